# Optimizing an MI355X kernel written in HIP

```python
import math
import jax, jax.numpy as jnp
from jax import lax
import numpy as np

D_MODEL = 2048
BATCH = 4
SEQ = 2048
DEPTH = 2

CTX_LEN = 256
GRID_W = 64
N_EVEN = (DEPTH + 1) // 2
N_ODD = DEPTH // 2
F32 = jnp.float32
EPS = 1e-6

A_HEAD_DIM = 128
A_WIDTH = D_MODEL // 2
A_HEADS = A_WIDTH // A_HEAD_DIM
A_CHUNK = 64
B_WIDTH = D_MODEL - A_WIDTH
CONV_W = 3
AB_SPLITS = [A_WIDTH, 2 * A_WIDTH, 3 * A_WIDTH, 4 * A_WIDTH, 5 * A_WIDTH,
             5 * A_WIDTH + B_WIDTH, 5 * A_WIDTH + 2 * B_WIDTH]
AB_IN_WIDTH = 5 * A_WIDTH + 3 * B_WIDTH
HY_ORDER = 2
HY_EMB = 33
HY_BANDS = (HY_EMB - 1) // 2
HY_FILTER_HIDDEN = 64
HY_DECAY_TARGET = 1e-2
HY_FAST_PCT = 0.3
HY_SLOW_PCT = 1.5
D_FF = 4 * D_MODEL

kernel_name = "hybrid_hgrn2_shortconv_hyena_dit"


def rmsnorm(x, g):
    xf = x.astype(F32)
    xf = xf * lax.rsqrt(jnp.mean(xf * xf, axis=-1, keepdims=True) + EPS)
    return xf.astype(x.dtype) * g


def conv3_seq(u, w):
    up = jnp.pad(u, ((0, 0), (1, 1), (0, 0)))
    return w[0] * up[:, :-2] + w[1] * up[:, 1:-1] + w[2] * up[:, 2:]


def conv3_grid(u, w):
    b, l, ch = u.shape
    rows = l // GRID_W
    return conv3_seq(u.reshape(b * rows, GRID_W, ch), w).reshape(b, l, ch)


def heads(t):
    return t.reshape(t.shape[:-1] + (A_HEADS, A_HEAD_DIM))


def rev(t):
    return jnp.flip(t, axis=1)


def hgrn_gates(z, lb):
    f = lb + (1.0 - lb) * jax.nn.sigmoid(z.astype(F32))
    return jnp.log(f), 1.0 - f


def hgrn_state(logf, k, v):
    b = jnp.cumsum(logf, axis=1)
    return jnp.einsum("blhk,blhv->bhkv", k * jnp.exp(b[:, -1:] - b), v)


def hgrn_scan(q, logf, k, v, s0):
    bsz, l, h, dh = q.shape
    n = l // A_CHUNK

    def chunks(t):
        return t.reshape(bsz, n, A_CHUNK, h, dh).transpose(1, 0, 3, 2, 4)

    past_in_chunk = jnp.tril(jnp.ones((A_CHUNK, A_CHUNK), dtype=bool))[:, :, None]

    def step(s, inp):
        qc, gc, kc, vc = inp
        b = jnp.cumsum(gc, axis=2)
        o_inter = jnp.einsum("bhtk,bhkv->bhtv", qc * jnp.exp(b), s)
        diff = jnp.where(past_in_chunk, b[:, :, :, None, :] - b[:, :, None, :, :], -jnp.inf)
        att = jnp.einsum("bhtk,bhsk,bhtsk->bhts", qc, kc, jnp.exp(diff))
        o_intra = jnp.einsum("bhts,bhsv->bhtv", att, vc)
        b_last = b[:, :, -1:, :]
        s_new = jnp.exp(b_last[:, :, 0, :])[..., None] * s + jnp.einsum(
            "bhsk,bhsv->bhkv", kc * jnp.exp(b_last - b), vc)
        return s_new, o_inter + o_intra

    s_fin, o = lax.scan(step, s0, (chunks(q), chunks(logf), chunks(k), chunks(v)))
    return o.transpose(1, 0, 3, 2, 4).reshape(bsz, l, h, dh), s_fin


def hgrn_bidir(q, zf_f, zf_b, v, lb, s0_f, s0_b):
    lg_f, k_f = hgrn_gates(zf_f, lb[0])
    lg_b, k_b = hgrn_gates(zf_b, lb[1])
    q, v = heads(q.astype(F32)), heads(v.astype(F32))
    o_f, s_f = hgrn_scan(q, heads(lg_f), heads(k_f), v, s0_f)
    o_b, s_b = hgrn_scan(rev(q), rev(heads(lg_b)), rev(heads(k_b)), rev(v), s0_b)
    return o_f + rev(o_b), s_f, s_b


def hgrn_context_states(zf_f, zf_b, v, lb):
    lg_f, k_f = hgrn_gates(zf_f, lb[0])
    lg_b, k_b = hgrn_gates(zf_b, lb[1])
    v = heads(v.astype(F32))
    s_f = hgrn_state(heads(lg_f), heads(k_f), v)
    s_b = hgrn_state(rev(heads(lg_b)), rev(heads(k_b)), rev(v))
    return s_f, s_b


def hgrn_readout(o, g, gnorm_g):
    on = rmsnorm(o, gnorm_g.reshape(A_HEADS, A_HEAD_DIM))
    return on.reshape(g.shape).astype(g.dtype) * jax.nn.silu(g)


def hgrn_conv_mixer(h, hc, w_in, conv_w, gnorm_g, w_out, lb, ctx_out):
    zf_f, zf_b, v, q, g, u, gb, gc = jnp.split(h @ w_in, AB_SPLITS, axis=-1)
    if ctx_out:
        czf_f, czf_b, cv, cq, cg, cu, cgb, cgc = jnp.split(hc @ w_in, AB_SPLITS, axis=-1)
        zero = jnp.zeros((hc.shape[0], A_HEADS, A_HEAD_DIM, A_HEAD_DIM), F32)
        oc, s_f, s_b = hgrn_bidir(cq, czf_f, czf_b, cv, lb, zero, zero)
        yc = jnp.concatenate([hgrn_readout(oc, cg, gnorm_g),
                              cgb * conv3_seq(cgc * cu, conv_w)], axis=-1) @ w_out
    else:
        czf_f, czf_b, cv = jnp.split(hc @ w_in[:, :3 * A_WIDTH], 3, axis=-1)
        s_f, s_b = hgrn_context_states(czf_f, czf_b, cv, lb)
        yc = None
    o, _, _ = hgrn_bidir(q, zf_f, zf_b, v, lb, s_f, s_b)
    y = jnp.concatenate([hgrn_readout(o, g, gnorm_g),
                         gb * conv3_grid(gc * u, conv_w)], axis=-1) @ w_out
    return y, yc


def hyena_filters(l, fw1, fb1, fw2, fb2, fw3, fb3, fw4, freq):
    pos = jnp.arange(l, dtype=F32)
    t = jnp.linspace(0.0, 1.0, l, dtype=F32)
    w = 2.0 * math.pi * pos / l
    bands = jnp.linspace(1e-4, HY_BANDS - 1, HY_BANDS, dtype=F32)
    ang = w[:, None] * bands[None, :]
    z = jnp.concatenate([t[:, None], jnp.cos(ang), -jnp.sin(ang)], axis=-1)
    freq = freq.astype(F32)
    hdn = jnp.sin(freq * (z @ fw1.astype(F32) + fb1.astype(F32)))
    hdn = jnp.sin(freq * (hdn @ fw2.astype(F32) + fb2.astype(F32)))
    hdn = jnp.sin(freq * (hdn @ fw3.astype(F32) + fb3.astype(F32)))
    filt = (hdn @ fw4.astype(F32)).reshape(l, HY_ORDER, 2, D_MODEL)
    max_decay = math.log(HY_DECAY_TARGET) / HY_FAST_PCT
    min_decay = math.log(HY_DECAY_TARGET) / HY_SLOW_PCT
    deltas = jnp.abs(jnp.linspace(min_decay, max_decay, D_MODEL, dtype=F32))
    window = jnp.exp(-t[:, None] * deltas[None, :])
    return filt * window[:, None, None, :]


def long_conv(z, filt, skip):
    l = z.shape[1]
    fw, bw = filt[:, 0], filt[:, 1]
    taps = jnp.concatenate([(fw[0] + bw[0])[None], fw[1:], jnp.zeros_like(fw[:1]), bw[:0:-1]], axis=0)
    taps = taps / jnp.sum(jnp.abs(taps), axis=0, keepdims=True)
    zf = z.astype(F32)
    y = jnp.fft.irfft(jnp.fft.rfft(zf, n=2 * l, axis=1) * jnp.fft.rfft(taps, n=2 * l, axis=0)[None],
                      n=2 * l, axis=1)[:, :l]
    return (y + zf * skip.astype(F32)).astype(z.dtype)


def hyena_mixer(h, in_w, short_w, out_w, fparams, skip, conv_fn):
    p = conv_fn(h @ in_w, short_w)
    x1, x2, z = jnp.split(p, 3, axis=-1)
    filt = hyena_filters(h.shape[1], *fparams)
    for o, gate in enumerate((x1, x2)):
        z = gate * long_conv(z, filt[:, o], skip[o])
    return z @ out_w


def sq_relu_mlp(h, w1, w2):
    return jnp.square(jax.nn.relu(h @ w1)) @ w2


def setup_inputs(seed: int = 0) -> dict:
    key = jax.random.key(seed)
    ks = jax.random.split(key, 32)
    D = D_MODEL

    def nrm(k, shape, scale):
        return scale * jax.random.normal(k, shape, F32)

    return {
        "x": nrm(ks[0], (BATCH, SEQ, D), 1.0),
        "c": nrm(ks[1], (BATCH, D), 1.0),
        "ctx": nrm(ks[2], (BATCH, CTX_LEN, D), 1.0),
        "c_ctx": nrm(ks[3], (D,), 1.0),
        "ada_w": nrm(ks[4], (DEPTH, D, 6 * D), D ** -0.5),
        "ada_b": nrm(ks[5], (DEPTH, 6 * D), 0.02),
        "norm_g": 1.0 + nrm(ks[6], (DEPTH, 2, D), 0.02),
        "lb_logits": nrm(ks[7], (2, DEPTH + 1, A_WIDTH), 0.5),
        "ab_w_in": nrm(ks[8], (N_EVEN, D, AB_IN_WIDTH), D ** -0.5),
        "ab_conv_w": nrm(ks[9], (N_EVEN, CONV_W, B_WIDTH), CONV_W ** -0.5),
        "ab_gnorm_g": 1.0 + nrm(ks[10], (N_EVEN, A_WIDTH), 0.02),
        "ab_w_out": nrm(ks[11], (N_EVEN, D, D), D ** -0.5),
        "hy_in_w": nrm(ks[12], (N_ODD, D, 3 * D), D ** -0.5),
        "hy_short_w": nrm(ks[13], (N_ODD, CONV_W, 3 * D), CONV_W ** -0.5),
        "hy_out_w": nrm(ks[14], (N_ODD, D, D), D ** -0.5),
        "hy_fw1": nrm(ks[15], (N_ODD, HY_EMB, HY_FILTER_HIDDEN), HY_EMB ** -0.5),
        "hy_fb1": nrm(ks[16], (N_ODD, HY_FILTER_HIDDEN), 0.02),
        "hy_fw2": nrm(ks[17], (N_ODD, HY_FILTER_HIDDEN, HY_FILTER_HIDDEN), HY_FILTER_HIDDEN ** -0.5),
        "hy_fb2": nrm(ks[18], (N_ODD, HY_FILTER_HIDDEN), 0.02),
        "hy_fw3": nrm(ks[19], (N_ODD, HY_FILTER_HIDDEN, HY_FILTER_HIDDEN), HY_FILTER_HIDDEN ** -0.5),
        "hy_fb3": nrm(ks[20], (N_ODD, HY_FILTER_HIDDEN), 0.02),
        "hy_fw4": nrm(ks[21], (N_ODD, HY_FILTER_HIDDEN, HY_ORDER * 2 * D), HY_FILTER_HIDDEN ** -0.5),
        "hy_freq": 1.0 + nrm(ks[22], (N_ODD, HY_FILTER_HIDDEN), 0.02),
        "hy_skip": nrm(ks[23], (N_ODD, HY_ORDER, D), 0.1),
        "mlp_w1": nrm(ks[24], (DEPTH, D, D_FF), D ** -0.5),
        "mlp_w2": nrm(ks[25], (DEPTH, D_FF, D), D_FF ** -0.5),
        "final_g": 1.0 + nrm(ks[26], (D,), 0.02),
    }


def reference(x, c, ctx, c_ctx, ada_w, ada_b, norm_g, lb_logits, ab_w_in, ab_conv_w, ab_gnorm_g,
              ab_w_out, hy_in_w, hy_short_w, hy_out_w, hy_fw1, hy_fb1, hy_fw2, hy_fb2, hy_fw3,
              hy_fb3, hy_fw4, hy_freq, hy_skip, mlp_w1, mlp_w2, final_g):
    lb_table = jnp.cumsum(jax.nn.softmax(lb_logits.astype(F32), axis=1), axis=1)
    silu_c = jax.nn.silu(c)
    silu_cc = jax.nn.silu(c_ctx)
    xc = ctx
    for l in range(DEPTH):
        even = l % 2 == 0
        ctx_out = any(j % 2 == 0 for j in range(l + 1, DEPTH))
        i = l // 2
        sh1, sc1, g1, sh2, sc2, g2 = [m[:, None, :] for m in
                                       jnp.split(silu_c @ ada_w[l] + ada_b[l], 6, axis=-1)]
        h = rmsnorm(x, norm_g[l, 0]) * (1.0 + sc1) + sh1
        hc, cmod = None, None
        if even or ctx_out:
            n_mod = 6 if ctx_out else 2
            cmod = jnp.split(silu_cc @ ada_w[l][:, :n_mod * D_MODEL] + ada_b[l][:n_mod * D_MODEL], n_mod)
            hc = rmsnorm(xc, norm_g[l, 0]) * (1.0 + cmod[1]) + cmod[0]
        if even:
            y, yc = hgrn_conv_mixer(h, hc, ab_w_in[i], ab_conv_w[i], ab_gnorm_g[i], ab_w_out[i],
                                    lb_table[:, l], ctx_out)
        else:
            fparams = (hy_fw1[i], hy_fb1[i], hy_fw2[i], hy_fb2[i], hy_fw3[i], hy_fb3[i], hy_fw4[i], hy_freq[i])
            y = hyena_mixer(h, hy_in_w[i], hy_short_w[i], hy_out_w[i], fparams, hy_skip[i], conv3_grid)
            yc = hyena_mixer(hc, hy_in_w[i], hy_short_w[i], hy_out_w[i], fparams, hy_skip[i],
                             conv3_seq) if ctx_out else None
        x = x + g1 * y
        x = x + g2 * sq_relu_mlp(rmsnorm(x, norm_g[l, 1]) * (1.0 + sc2) + sh2, mlp_w1[l], mlp_w2[l])
        if ctx_out:
            xc = xc + cmod[2] * yc
            xc = xc + cmod[5] * sq_relu_mlp(rmsnorm(xc, norm_g[l, 1]) * (1.0 + cmod[4]) + cmod[3],
                                            mlp_w1[l], mlp_w2[l])
    return rmsnorm(x, final_g)
```

```cpp
#include <hip/hip_runtime.h>
#include <hip/hip_cooperative_groups.h>
#include <cstdio>
#include <cstdint>
namespace cg = cooperative_groups;
namespace pg8 {
#define PG8_LAS __attribute__((address_space(3)))
typedef unsigned short bf16_t;
typedef short bf16x8 __attribute__((ext_vector_type(8)));
typedef float f32x4 __attribute__((ext_vector_type(4)));
typedef unsigned u32x4 __attribute__((ext_vector_type(4)));
constexpr int BM = 256, BK = 64, HALF = 128, HTB = HALF * BK * 2  , STAGE_BYTES = 8 * HTB, NXCD = 8, WGM = 8;

__host__ __device__ __forceinline__ int lds_byte(int r, int c) { const int st = (r >> 4) * 2 + (c >> 5), rr = r & 15, cc = c & 31, ob = rr * 64 + cc * 2; return st * 1024 + (ob ^ (((ob >> 9) & 1) << 5)); }
__host__ __device__ __forceinline__ void stage_rc(int b, int& R, int& C) { const int st = b / 1024, sb = b % 1024, swz = sb ^ (((sb >> 9) & 1) << 5); R = (st >> 1) * 16 + swz / 64; C = (st & 1) * 32 + (swz % 64) / 2; }
__host__ __device__ __forceinline__ int perm32(int rho) { const int n = rho >> 4, i = rho & 15; return 8 * (i >> 2) + 4 * n + (i & 3); }

struct Unit { int pm, pn; };
struct Gemm { const bf16_t* A; const bf16_t* Bt; int M, N, K; };

struct StaticOrder {
    int nM, nN, nwg, G, c;
    __host__ __device__ void init(int M, int N, int G_, int c_) { nM = M / BM; nN = N / BM; nwg = nM * nN; G = G_; c = c_; }
    __host__ __device__ bool next(int i, Unit& u) const {
        const long L = (long)i * G + c; if (L >= nwg) return false;
        int wgid = (int)L; { const int q = nwg / NXCD, r = nwg % NXCD, xcd = wgid % NXCD, off = wgid / NXCD; wgid = (xcd < r ? xcd * (q + 1) : r * (q + 1) + (xcd - r) * q) + off; }
        const int nig = WGM * nN, gid = wgid / nig, fm = gid * WGM, gsz = (nM - fm) < WGM ? (nM - fm) : WGM;
        u.pm = fm + ((wgid % nig) % gsz); u.pn = (wgid % nig) / gsz; return true;
    }
    __device__ __forceinline__ void a_ready(const Unit&) const {}
    __device__ __forceinline__ void done(const Unit&) const {}
};
__device__ __forceinline__ unsigned cvt_pk_bf16(float lo, float hi) { unsigned r; asm volatile("v_cvt_pk_bf16_f32 %0, %1, %2" : "=v"(r) : "v"(lo), "v"(hi)); return r; }
template <class Epi, class Sched, bool ALIGN_EPI = false, bool SP2 = false>
__device__ __forceinline__ void gemm_phase(PG8_LAS unsigned char* lds, const Gemm g, const Sched& S, const Epi& E) {
    const int tid = threadIdx.x, wid = __builtin_amdgcn_readfirstlane(tid >> 6), lane = tid & 63, wr = wid >> 2, wc = wid & 3, fr = lane & 15, fq = lane >> 4;
    const int K = g.K, nt = K / BK;
    unsigned voffA[2], voffB[2];
#pragma unroll
    for (int i = 0; i < 2; ++i) { int R, C; stage_rc(tid * 16 + i * 8192, R, C); const int Rb = Epi::PERM ? ((R & ~31) + perm32(R & 31)) : R;
        voffA[i] = (unsigned)(R * K + C) * 2u; voffB[i] = (unsigned)(Rb * K + C) * 2u; }
    const size_t kstep = (size_t)(BK * 2);
    const size_t hstep = (size_t)HALF * K * 2;
    const size_t tstep = 2 * hstep;
    const unsigned ldsw = (unsigned)wid * 1024u;
    const int aoff = lds_byte(wr * 64 + fr, fq * 8), boff = lds_byte(wc * 32 + fr, fq * 8);
#define PG8_SA(b, h) (((b) * 2 + (h)) * HTB)
#define PG8_SB(b, h) ((4 + (b) * 2 + (h)) * HTB)
#define PG8_STAGE(bufoff, gbase, voff) do { _Pragma("unroll") for (int _i = 0; _i < 2; ++_i) \
        __builtin_amdgcn_global_load_lds((const unsigned*)((const char*)(gbase) + (voff)[_i]), (PG8_LAS unsigned*)(lds + (bufoff) + ldsw + _i * 8192), 16, 0, 0); } while (0)
#define PG8_LDA(dst, b, h) do { _Pragma("unroll") for (int m = 0; m < 4; ++m) _Pragma("unroll") for (int k = 0; k < 2; ++k) dst[m][k] = *(const PG8_LAS bf16x8*)(lds + PG8_SA(b, h) + aoff + m * 2048 + k * 1024); } while (0)
#define PG8_LDB(dst, b, h) do { _Pragma("unroll") for (int n = 0; n < 2; ++n) _Pragma("unroll") for (int k = 0; k < 2; ++k) dst[n][k] = *(const PG8_LAS bf16x8*)(lds + PG8_SB(b, h) + boff + n * 2048 + k * 1024); } while (0)
#define PG8_MMA(ai, bj, At, Bt) do { __builtin_amdgcn_s_setprio(1); _Pragma("unroll") for (int m = 0; m < 4; ++m) _Pragma("unroll") for (int n = 0; n < 2; ++n) _Pragma("unroll") for (int k = 0; k < 2; ++k) \
        acc[ai][bj][m][n] = __builtin_amdgcn_mfma_f32_16x16x32_bf16(Bt[n][k], At[m][k], acc[ai][bj][m][n], 0, 0, 0); __builtin_amdgcn_s_setprio(0); } while (0)
#define PG8_WAIT_V(n) asm volatile("s_waitcnt vmcnt(" #n ")" ::: "memory")
#define PG8_WAIT_L(n) asm volatile("s_waitcnt lgkmcnt(" #n ")" ::: "memory")
#define PG8_BAR __builtin_amdgcn_s_barrier()
#define PG8_SCHED __builtin_amdgcn_sched_barrier(0)
    Unit cur, nxt; int ui = 0;
    if (!S.next(0, cur)) return;
    f32x4 acc[2][2][4][2];
#pragma unroll
    for (int a = 0; a < 2; ++a)
#pragma unroll
        for (int b = 0; b < 2; ++b)
#pragma unroll
            for (int m = 0; m < 4; ++m)
#pragma unroll
                for (int n = 0; n < 2; ++n) acc[a][b][m][n] = (f32x4){0.f, 0.f, 0.f, 0.f};
    bf16x8 At[4][2], B0[2][2], B1[2][2];
    const char* cA = (const char*)g.A + (size_t)cur.pm * tstep; const char* cB = (const char*)g.Bt + (size_t)cur.pn * tstep;
    S.a_ready(cur);
    if constexpr (SP2) {
        PG8_STAGE(PG8_SB(0, 0), cB, voffB); PG8_STAGE(PG8_SB(0, 1), cB + hstep, voffB); PG8_STAGE(PG8_SA(0, 0), cA, voffA); PG8_STAGE(PG8_SA(0, 1), cA + hstep, voffA);
        if (wr == 1) PG8_BAR;
        PG8_WAIT_V(2); PG8_BAR;
        PG8_STAGE(PG8_SB(1, 0), cB + kstep, voffB); PG8_STAGE(PG8_SA(1, 0), cA + kstep, voffA); PG8_STAGE(PG8_SB(1, 1), cB + hstep + kstep, voffB);
        PG8_WAIT_V(6); PG8_BAR;
    } else {
        PG8_STAGE(PG8_SB(0, 0), cB, voffB); PG8_STAGE(PG8_SA(0, 0), cA, voffA); PG8_STAGE(PG8_SB(0, 1), cB + hstep, voffB); PG8_STAGE(PG8_SA(0, 1), cA + hstep, voffA);
        if (wr == 1) PG8_BAR;
        PG8_WAIT_V(4); PG8_BAR;
        PG8_STAGE(PG8_SB(1, 0), cB + kstep, voffB); PG8_STAGE(PG8_SA(1, 0), cA + kstep, voffA); PG8_STAGE(PG8_SB(1, 1), cB + hstep + kstep, voffB);
        PG8_WAIT_V(6); PG8_BAR;
    }
    for (;;) {
        const bool has_next = S.next(ui + 1, nxt);
        const char* nA = has_next ? (const char*)g.A + (size_t)nxt.pm * tstep : cA; const char* nB = has_next ? (const char*)g.Bt + (size_t)nxt.pn * tstep : cB;
        for (int t = 0; t < nt; t += 2) {
            const bool last = (t == nt - 2);
            const char* a1 = cA + (size_t)(t + 1) * kstep;
            const char* a2 = last ? nA : cA + (size_t)(t + 2) * kstep; const char* b2 = last ? nB : cB + (size_t)(t + 2) * kstep;
            const char* a3 = a2 + kstep; const char* b3 = b2 + kstep;
            if (last && has_next) S.a_ready(nxt);
            if constexpr (SP2) {
            PG8_LDB(B0, 0, 0); PG8_LDB(B1, 0, 1); PG8_SCHED; PG8_LDA(At, 0, 0); PG8_STAGE(PG8_SA(1, 1), a1 + hstep, voffA);
            PG8_WAIT_V(8); PG8_WAIT_L(0); PG8_BAR; PG8_MMA(0, 0, At, B0); PG8_MMA(0, 1, At, B1); PG8_BAR; PG8_SCHED;
            PG8_LDA(At, 0, 1); PG8_STAGE(PG8_SB(0, 0), b2, voffB); PG8_STAGE(PG8_SB(0, 1), b2 + hstep, voffB); PG8_STAGE(PG8_SA(0, 0), a2, voffA);
            PG8_WAIT_V(8); PG8_WAIT_L(0); PG8_BAR; PG8_MMA(1, 0, At, B0); PG8_MMA(1, 1, At, B1); PG8_BAR; PG8_SCHED;
            PG8_LDB(B0, 1, 0); PG8_LDB(B1, 1, 1); PG8_SCHED; PG8_LDA(At, 1, 0); PG8_STAGE(PG8_SA(0, 1), a2 + hstep, voffA);
            PG8_WAIT_V(8); PG8_WAIT_L(0); PG8_BAR; PG8_MMA(0, 0, At, B0); PG8_MMA(0, 1, At, B1); PG8_BAR; PG8_SCHED;
            PG8_LDA(At, 1, 1); PG8_STAGE(PG8_SB(1, 0), b3, voffB); PG8_STAGE(PG8_SB(1, 1), b3 + hstep, voffB); PG8_STAGE(PG8_SA(1, 0), a3, voffA);
            PG8_WAIT_V(8); PG8_WAIT_L(0); PG8_BAR; PG8_MMA(1, 0, At, B0); PG8_MMA(1, 1, At, B1); PG8_BAR; PG8_SCHED;
            } else {
            PG8_LDB(B0, 0, 0); PG8_SCHED; PG8_LDA(At, 0, 0); PG8_STAGE(PG8_SA(1, 1), a1 + hstep, voffA);
            PG8_WAIT_L(8); PG8_BAR; PG8_WAIT_L(0); PG8_MMA(0, 0, At, B0); PG8_BAR; PG8_SCHED;
            PG8_LDB(B1, 0, 1); PG8_STAGE(PG8_SB(0, 0), b2, voffB);
            PG8_BAR; PG8_WAIT_L(0); PG8_MMA(0, 1, At, B1); PG8_BAR;
            PG8_LDA(At, 0, 1); PG8_STAGE(PG8_SA(0, 0), a2, voffA);
            PG8_BAR; PG8_WAIT_L(0); PG8_MMA(1, 0, At, B0); PG8_BAR; PG8_SCHED;
            PG8_STAGE(PG8_SB(0, 1), b2 + hstep, voffB);
            PG8_WAIT_V(6); PG8_BAR; PG8_MMA(1, 1, At, B1); PG8_BAR;
            PG8_LDB(B0, 1, 0); PG8_SCHED; PG8_LDA(At, 1, 0); PG8_STAGE(PG8_SA(0, 1), a2 + hstep, voffA);
            PG8_WAIT_L(8); PG8_BAR; PG8_WAIT_L(0); PG8_MMA(0, 0, At, B0); PG8_BAR; PG8_SCHED;
            PG8_LDB(B1, 1, 1); PG8_STAGE(PG8_SB(1, 0), b3, voffB);
            PG8_BAR; PG8_WAIT_L(0); PG8_MMA(0, 1, At, B1); PG8_BAR;
            PG8_LDA(At, 1, 1); PG8_STAGE(PG8_SA(1, 0), a3, voffA);
            PG8_BAR; PG8_WAIT_L(0); PG8_MMA(1, 0, At, B0); PG8_BAR; PG8_SCHED;
            PG8_STAGE(PG8_SB(1, 1), b3 + hstep, voffB);
            PG8_WAIT_V(6); PG8_BAR; PG8_MMA(1, 1, At, B1); PG8_BAR;
            }
        }
        if constexpr (ALIGN_EPI) { if (wr == 0) PG8_BAR; }
        if constexpr (!Epi::AFTER_DRAIN) { E(acc, cur, wr, wc, fr, fq); S.done(cur); }
        if (!has_next) break;
#pragma unroll
        for (int a = 0; a < 2; ++a)
#pragma unroll
            for (int b = 0; b < 2; ++b)
#pragma unroll
                for (int m = 0; m < 4; ++m)
#pragma unroll
                    for (int n = 0; n < 2; ++n) acc[a][b][m][n] = (f32x4){0.f, 0.f, 0.f, 0.f};
        cur = nxt; cA = nA; cB = nB; ++ui;
        if constexpr (ALIGN_EPI) { if (wr == 1) PG8_BAR; }
    }
    PG8_WAIT_V(0);
    if constexpr (!ALIGN_EPI) { if (wr == 0) PG8_BAR; }
    PG8_BAR;
    if constexpr (Epi::AFTER_DRAIN) { E.fused(acc, cur, wr, wc, fr, fq, lds, wid, lane); S.done(cur); }
#undef PG8_SA
#undef PG8_SB
#undef PG8_STAGE
#undef PG8_LDA
#undef PG8_LDB
#undef PG8_MMA
#undef PG8_WAIT_V
#undef PG8_WAIT_L
#undef PG8_BAR
#undef PG8_SCHED
}
}
typedef unsigned short bf16_t;
#define DEV __device__ __forceinline__
constexpr int DM = 2048, NB = 4, SEQ = 2048, MTOK = NB * SEQ, CTXL = 256, MCTX = NB * CTXL, FF = 8192, AW = 1024, NH = 8, DH = 128;
constexpr int NAB = 8192, NHY = 6144;
constexpr float EPS = 1e-6f;
constexpr int LDS_BYTES = 163840;
constexpr size_t SZ_W8K = (size_t)8192 * 2048 * 2, SZ_W2K = (size_t)2048 * 2048 * 2;
constexpr size_t OFF_WIN = 0, OFF_WOUT = OFF_WIN + SZ_W8K, OFF_W1_0 = OFF_WOUT + SZ_W2K, OFF_W2_0 = OFF_W1_0 + SZ_W8K, OFF_HYIN = OFF_W2_0 + SZ_W8K,
                 OFF_HYOUT = OFF_HYIN + (size_t)6144 * 2048 * 2, OFF_W1_1 = OFF_HYOUT + SZ_W2K, OFF_W2_1 = OFF_W1_1 + SZ_W8K, OFF_MOD = OFF_W2_1 + SZ_W8K,
                 OFF_HDN = OFF_MOD + 524288, OFF_H = OFF_HDN + 524288, OFF_BIG = OFF_H + (size_t)9216 * 2048 * 2, OFF_Y = OFF_BIG + (size_t)9216 * 8192 * 2,
                 OFF_X1 = OFF_Y + (size_t)8192 * 2048 * 2, OFF_X2 = OFF_X1 + (size_t)8192 * 2048 * 4, OFF_T1 = OFF_X2 + (size_t)8192 * 2048 * 4,
                 OFF_T2 = OFF_T1 + (size_t)67108864, WS_END = OFF_T2 + (size_t)3 * 33554432;

struct Params {
    const float *x, *c, *ctx, *c_ctx, *ada_w, *ada_b, *norm_g, *lb_logits, *ab_w_in, *ab_conv_w, *ab_gnorm_g, *ab_w_out, *hy_in_w, *hy_short_w, *hy_out_w,
        *fw1, *fb1, *fw2, *fb2, *fw3, *fb3, *fw4, *freq, *skip, *w1, *w2, *final_g;
    float* out; unsigned char* ws; int ph_lo, ph_hi;
};

DEV float bf2f(bf16_t b) { return __uint_as_float(((unsigned)b) << 16); }
DEV unsigned pk2(float lo, float hi) { return pg8::cvt_pk_bf16(lo, hi); }
DEV bf16_t f2bf(float v) { return (bf16_t)(pk2(v, 0.f) & 0xffffu); }
DEV float wave_sum(float v) {
#pragma unroll
    for (int o = 1; o < 64; o <<= 1) v += __shfl_xor(v, o);
    return v;
}
DEV float sigm(float x) { return 1.f / (1.f + __expf(-x)); }
DEV float siluf(float x) { return x / (1.f + __expf(-x)); }
DEV void lds_fence() { asm volatile("s_waitcnt lgkmcnt(0)" ::: "memory"); __builtin_amdgcn_wave_barrier(); }

typedef unsigned u32x4v __attribute__((ext_vector_type(4)));
template <int ACT> struct EpiBf16 {
    static constexpr bool PERM = true, AFTER_DRAIN = false;
    bf16_t* O; int ldc;
    __device__ __forceinline__ void operator()(const pg8::f32x4 (&acc)[2][2][4][2], const pg8::Unit& u, int wr, int wc, int fr, int fq) const {
        const int row0 = u.pm * 256 + wr * 64 + fr, col0 = u.pn * 256 + wc * 32 + 8 * fq;
#pragma unroll
        for (int ai = 0; ai < 2; ++ai)
#pragma unroll
            for (int m = 0; m < 4; ++m) { bf16_t* rowp = O + (size_t)(row0 + ai * 128 + m * 16) * ldc + col0;
#pragma unroll
                for (int bj = 0; bj < 2; ++bj) { pg8::f32x4 v0 = acc[ai][bj][m][0], v1 = acc[ai][bj][m][1];
                    if (ACT == 1) {
#pragma unroll
                        for (int e = 0; e < 4; ++e) { float a = fmaxf(v0[e], 0.f), b = fmaxf(v1[e], 0.f); v0[e] = a * a; v1[e] = b * b; } }
                    u32x4v w; w.x = pk2(v0[0], v0[1]); w.y = pk2(v0[2], v0[3]); w.z = pk2(v1[0], v1[1]); w.w = pk2(v1[2], v1[3]);
                    *(u32x4v*)(rowp + bj * 128) = w; } }
    }
};
struct EpiResid {
    static constexpr bool PERM = false, AFTER_DRAIN = false;
    float* C; const float* R; const float* gate; int gstride;
    __device__ __forceinline__ void operator()(const pg8::f32x4 (&acc)[2][2][4][2], const pg8::Unit& u, int wr, int wc, int fr, int fq) const {
        const int row0 = u.pm * 256 + wr * 64 + fr, col0 = u.pn * 256 + wc * 32 + 4 * fq;
        const float* gp = gate + (size_t)((u.pm * 256) >> 11) * gstride + col0;
        pg8::f32x4 gv[2][2];
#pragma unroll
        for (int bj = 0; bj < 2; ++bj)
#pragma unroll
            for (int n = 0; n < 2; ++n) gv[bj][n] = *(const pg8::f32x4*)(gp + bj * 128 + n * 16);
#pragma unroll
        for (int ai = 0; ai < 2; ++ai)
#pragma unroll
            for (int m = 0; m < 4; ++m) { const size_t ro = (size_t)(row0 + ai * 128 + m * 16) * DM + col0;
#pragma unroll
                for (int bj = 0; bj < 2; ++bj)
#pragma unroll
                    for (int n = 0; n < 2; ++n) { const pg8::f32x4 r = *(const pg8::f32x4*)(R + ro + bj * 128 + n * 16);
                        *(pg8::f32x4*)(C + ro + bj * 128 + n * 16) = r + gv[bj][n] * acc[ai][bj][m][n]; } }
    }
};
struct OrderX {
    int nM, nN, nwg, G, c, ex_n, ex_pm0, ex_nN;
    __device__ void init(int M, int N, int G_, int c_, int exn, int expm0, int exnN) { nM = M / 256; nN = N / 256; nwg = nM * nN; G = G_; c = c_; ex_n = exn; ex_pm0 = expm0; ex_nN = exnN; }
    __device__ bool next(int i, pg8::Unit& u) const {
        const long L = (long)i * G + c; if (L >= nwg + ex_n) return false;
        if (L >= nwg) { const int e = (int)L - nwg; u.pm = ex_pm0 + e / ex_nN; u.pn = e % ex_nN; return true; }
        int wgid = (int)L; { const int q = nwg / 8, r = nwg % 8, xcd = wgid % 8, off = wgid / 8; wgid = (xcd < r ? xcd * (q + 1) : r * (q + 1) + (xcd - r) * q) + off; }
        const int nig = 8 * nN, gid = wgid / nig, fm = gid * 8, gsz = (nM - fm) < 8 ? (nM - fm) : 8;
        u.pm = fm + ((wgid % nig) % gsz); u.pn = (wgid % nig) / gsz; return true;
    }
    __device__ __forceinline__ void a_ready(const pg8::Unit&) const {}
    __device__ __forceinline__ void done(const pg8::Unit&) const {}
};

DEV void transpose_item(const float* __restrict__ W, int K, int N, bf16_t* __restrict__ WT, float* scr, int item, int lane) {
    const int nblk = N / 32, kb = item / nblk, nb = item % nblk, k0 = 64 * kb, n0 = 32 * nb;
#pragma unroll 8
    for (int i = 0; i < 32; ++i) { const int kk = 2 * i + (lane >> 5); scr[kk * 33 + (lane & 31)] = W[(size_t)(k0 + kk) * N + n0 + (lane & 31)]; }
    lds_fence();
    const int c = lane & 7;
#pragma unroll
    for (int j = 0; j < 4; ++j) { const int n = (lane >> 3) + 8 * j; const float* s = scr + (8 * c) * 33 + n;
        u32x4v o; o.x = pk2(s[0], s[33]); o.y = pk2(s[2 * 33], s[3 * 33]); o.z = pk2(s[4 * 33], s[5 * 33]); o.w = pk2(s[6 * 33], s[7 * 33]);
        *(u32x4v*)(WT + (size_t)(n0 + n) * K + k0 + 8 * c) = o; }
    lds_fence();
}
DEV void phase_convert(const Params& p, unsigned char* shm) {
    const int wave = threadIdx.x >> 6, lane = threadIdx.x & 63;
    float* scr = (float*)shm + wave * (64 * 33);
    const int gw = blockIdx.x * 8 + wave, NGW = gridDim.x * 8;
    constexpr int I8 = 32 * 256, I2 = 32 * 64, I6 = 32 * 192, IW2 = 128 * 64;
    constexpr int NIT = I8 + I2 + I8 + IW2 + I6 + I2 + I8 + IW2;
    for (int it = gw; it < NIT; it += NGW) {
        int r = it;
        if (r < I8) { transpose_item(p.ab_w_in, 2048, 8192, (bf16_t*)(p.ws + OFF_WIN), scr, r, lane); continue; } r -= I8;
        if (r < I2) { transpose_item(p.ab_w_out, 2048, 2048, (bf16_t*)(p.ws + OFF_WOUT), scr, r, lane); continue; } r -= I2;
        if (r < I8) { transpose_item(p.w1, 2048, 8192, (bf16_t*)(p.ws + OFF_W1_0), scr, r, lane); continue; } r -= I8;
        if (r < IW2) { transpose_item(p.w2, 8192, 2048, (bf16_t*)(p.ws + OFF_W2_0), scr, r, lane); continue; } r -= IW2;
        if (r < I6) { transpose_item(p.hy_in_w, 2048, 6144, (bf16_t*)(p.ws + OFF_HYIN), scr, r, lane); continue; } r -= I6;
        if (r < I2) { transpose_item(p.hy_out_w, 2048, 2048, (bf16_t*)(p.ws + OFF_HYOUT), scr, r, lane); continue; } r -= I2;
        if (r < I8) { transpose_item(p.w1 + (size_t)2048 * 8192, 2048, 8192, (bf16_t*)(p.ws + OFF_W1_1), scr, r, lane); continue; } r -= I8;
        transpose_item(p.w2 + (size_t)8192 * 2048, 8192, 2048, (bf16_t*)(p.ws + OFF_W2_1), scr, r, lane);
    }
    __syncthreads();
}
DEV void phase_ada(const Params& p, unsigned char* shm) {
    float* sil = (float*)shm;
    float* red = sil + 5 * 2080;
    const int tid = threadIdx.x;
    for (int i = tid; i < 5 * 2048; i += 512) { const int m = i >> 11, k = i & 2047; const float v = m < 4 ? p.c[m * 2048 + k] : p.c_ctx[k]; sil[m * 2080 + k + (k >> 6)] = siluf(v); }
    __syncthreads();
    float* MOD = (float*)(p.ws + OFF_MOD);
    const int cq = tid & 15, kg = tid >> 4;
    for (int u = blockIdx.x; u < 384; u += gridDim.x) {
        const int l = u / 192, n0 = (u % 192) * 64;
        float acc[5][4];
#pragma unroll
        for (int m = 0; m < 5; ++m)
#pragma unroll
            for (int e = 0; e < 4; ++e) acc[m][e] = 0.f;
        const float* wp = p.ada_w + ((size_t)l * 2048 + kg * 64) * 12288 + n0 + cq * 4;
#pragma unroll 4
        for (int k = 0; k < 64; ++k) { const pg8::f32x4 w = *(const pg8::f32x4*)(wp + (size_t)k * 12288);
#pragma unroll
            for (int m = 0; m < 5; ++m) { const float s = sil[m * 2080 + kg * 65 + k];
#pragma unroll
                for (int e = 0; e < 4; ++e) acc[m][e] += s * w[e]; } }
#pragma unroll
        for (int m = 0; m < 5; ++m)
#pragma unroll
            for (int e = 0; e < 4; ++e) red[(kg * 5 + m) * 64 + cq * 4 + e] = acc[m][e];
        __syncthreads();
        if (tid < 320) { const int m = tid >> 6, n = tid & 63; float s = p.ada_b[l * 12288 + n0 + n];
            for (int g = 0; g < 32; ++g) s += red[(g * 5 + m) * 64 + n];
            MOD[((size_t)l * 5 + m) * 12288 + n0 + n] = s; }
        __syncthreads();
    }
}
DEV void phase_hdn(const Params& p, unsigned char* shm) {
    float* zb = (float*)shm; float* ha = zb + 512; float* hb = ha + 512;
    float* HDN = (float*)(p.ws + OFF_HDN);
    const int tid = threadIdx.x, pl = tid >> 6, j = tid & 63;
    for (int pb = blockIdx.x; pb < 256; pb += gridDim.x) {
        const int pos = pb * 8 + pl;
        if (j < 33) { float val;
            if (j == 0) val = (float)pos / 2047.f;
            else { const int bi = (j - 1) & 15; const float band = 1e-4f + (float)bi * ((15.f - 1e-4f) / 15.f); const float w = 6.283185307179586f * (float)pos / 2048.f; const float ang = w * band;
                val = (j <= 16) ? cosf(ang) : -sinf(ang); }
            zb[pl * 64 + j] = val; }
        __syncthreads();
        const float fq = p.freq[j];
        float a = p.fb1[j];
#pragma unroll 3
        for (int i = 0; i < 33; ++i) a += zb[pl * 64 + i] * p.fw1[i * 64 + j];
        ha[pl * 64 + j] = sinf(fq * a);
        __syncthreads();
        a = p.fb2[j];
#pragma unroll 4
        for (int i = 0; i < 64; ++i) a += ha[pl * 64 + i] * p.fw2[i * 64 + j];
        hb[pl * 64 + j] = sinf(fq * a);
        __syncthreads();
        a = p.fb3[j];
#pragma unroll 4
        for (int i = 0; i < 64; ++i) a += hb[pl * 64 + i] * p.fw3[i * 64 + j];
        HDN[pos * 64 + j] = sinf(fq * a);
        __syncthreads();
    }
}
DEV void phase_taps(const Params& p) {
    const float* HDN = (const float*)(p.ws + OFF_HDN);
    float* TAPS = (float*)(p.ws + OFF_T1);
    const int lane = threadIdx.x & 63, wv = __builtin_amdgcn_readfirstlane(threadIdx.x >> 6);
    const float min_decay = -3.0701134573253943f, max_decay = -15.350567286626972f;
    for (int unit = blockIdx.x; unit < 2048; unit += gridDim.x) {
        const int pt = unit & 31, dt = (unit >> 5) & 31, o = unit >> 10;
        const int pos = pt * 64 + lane;
        float hd[64];
#pragma unroll
        for (int j = 0; j < 16; ++j) { const pg8::f32x4 v = *(const pg8::f32x4*)(HDN + pos * 64 + 4 * j); hd[4 * j] = v[0]; hd[4 * j + 1] = v[1]; hd[4 * j + 2] = v[2]; hd[4 * j + 3] = v[3]; }
        const float tt = (float)pos / 2047.f;
        for (int cc = 0; cc < 8; ++cc) {
            const int d = dt * 64 + wv * 8 + cc;
            const float* f4 = p.fw4 + o * 4096 + d;
            float af = 0.f, ab = 0.f;
#pragma unroll
            for (int j = 0; j < 64; ++j) { af += hd[j] * f4[j * 8192]; ab += hd[j] * f4[j * 8192 + 2048]; }
            const float delta = fabsf(min_decay + (float)d * ((max_decay - min_decay) / 2047.f));
            const float win = expf(-tt * delta);
            af *= win; ab *= win;
            float* T = TAPS + ((size_t)(o * 2048 + d)) * 4096;
            if (pos == 0) { T[2048] = af + ab; T[0] = 0.f; } else { T[2048 + pos] = af; T[2048 - pos] = ab; }
        }
    }
}
DEV void norm_rows(const float* __restrict__ X, int nrows, int rows_per_batch, const float* __restrict__ g, const float* __restrict__ mod, int mstride, int sh_off, int sc_off, bf16_t* __restrict__ O) {
    const int wave = threadIdx.x >> 6, lane = threadIdx.x & 63;
    const int gw = blockIdx.x * 8 + wave, NGW = gridDim.x * 8;
    for (int row = gw; row < nrows; row += NGW) {
        const pg8::f32x4* xr = (const pg8::f32x4*)(X + (size_t)row * DM) + lane;
        pg8::f32x4 v[8]; float s = 0.f;
#pragma unroll
        for (int j = 0; j < 8; ++j) { v[j] = xr[64 * j]; s += (v[j][0] * v[j][0] + v[j][1] * v[j][1]) + (v[j][2] * v[j][2] + v[j][3] * v[j][3]); }
        const float rstd = rsqrtf(wave_sum(s) * (1.f / DM) + EPS);
        const float* mb = mod + (size_t)(row / rows_per_batch) * mstride;
        unsigned long long* o8 = (unsigned long long*)(O + (size_t)row * DM) + lane;
#pragma unroll
        for (int j = 0; j < 8; ++j) { const int cidx = 4 * (lane + 64 * j);
            const pg8::f32x4 gg = *(const pg8::f32x4*)(g + cidx), sh = *(const pg8::f32x4*)(mb + sh_off + cidx), sc = *(const pg8::f32x4*)(mb + sc_off + cidx);
            float r[4];
#pragma unroll
            for (int e = 0; e < 4; ++e) r[e] = v[j][e] * rstd * gg[e] * (1.f + sc[e]) + sh[e];
            o8[64 * j] = (unsigned long long)pk2(r[0], r[1]) | ((unsigned long long)pk2(r[2], r[3]) << 32); }
    }
}
DEV void final_norm_rows(const float* __restrict__ X, const float* __restrict__ g, float* __restrict__ O) {
    const int wave = threadIdx.x >> 6, lane = threadIdx.x & 63;
    const int gw = blockIdx.x * 8 + wave, NGW = gridDim.x * 8;
    for (int row = gw; row < MTOK; row += NGW) {
        const pg8::f32x4* xr = (const pg8::f32x4*)(X + (size_t)row * DM) + lane;
        pg8::f32x4 v[8]; float s = 0.f;
#pragma unroll
        for (int j = 0; j < 8; ++j) { v[j] = xr[64 * j]; s += (v[j][0] * v[j][0] + v[j][1] * v[j][1]) + (v[j][2] * v[j][2] + v[j][3] * v[j][3]); }
        const float rstd = rsqrtf(wave_sum(s) * (1.f / DM) + EPS);
        pg8::f32x4* orow = (pg8::f32x4*)(O + (size_t)row * DM) + lane;
#pragma unroll
        for (int j = 0; j < 8; ++j) { const pg8::f32x4 gg = *(const pg8::f32x4*)(g + 4 * (lane + 64 * j)); orow[64 * j] = v[j] * rstd * gg; }
    }
}
DEV void phase_convbranch(const Params& p) {
    const bf16_t* PROJ = (const bf16_t*)(p.ws + OFF_BIG);
    bf16_t* Y = (bf16_t*)(p.ws + OFF_Y);
    for (int item = blockIdx.x * 512 + threadIdx.x; item < MTOK * 128; item += gridDim.x * 512) {
        const int row = item >> 7, c = (item & 127) * 8, t = row & 63;
        float acc[8];
#pragma unroll
        for (int e = 0; e < 8; ++e) acc[e] = 0.f;
#pragma unroll
        for (int dt = -1; dt <= 1; ++dt) {
            if ((dt < 0 && t == 0) || (dt > 0 && t == 63)) continue;
            const bf16_t* rp = PROJ + (size_t)(row + dt) * NAB;
            const u32x4v uu = *(const u32x4v*)(rp + 5120 + c), gc = *(const u32x4v*)(rp + 7168 + c);
            const float* w = p.ab_conv_w + (dt + 1) * 1024 + c;
#pragma unroll
            for (int e = 0; e < 4; ++e) { const unsigned a = uu[e], b = gc[e];
                acc[2 * e] += w[2 * e] * (__uint_as_float(a << 16) * __uint_as_float(b << 16));
                acc[2 * e + 1] += w[2 * e + 1] * (__uint_as_float(a & 0xffff0000u) * __uint_as_float(b & 0xffff0000u)); }
        }
        const u32x4v gb = *(const u32x4v*)(PROJ + (size_t)row * NAB + 6144 + c);
        u32x4v o;
#pragma unroll
        for (int e = 0; e < 4; ++e) o[e] = pk2(acc[2 * e] * __uint_as_float(gb[e] << 16), acc[2 * e + 1] * __uint_as_float(gb[e] & 0xffff0000u));
        *(u32x4v*)(Y + (size_t)row * DM + 1024 + c) = o;
    }
}
DEV void phase_scan_naive(const Params& p, unsigned char* shm) {
    float* Fb = (float*)shm;
    float* Kb = Fb + 4096; float* Qb = Kb + 4096;
    float* Vb = Qb + 4096;
    float* Op = Vb + 1024;
    const bf16_t* PROJ = (const bf16_t*)(p.ws + OFF_BIG);
    const bf16_t* CPROJ = PROJ + (size_t)MTOK * NAB;
    float* OFB = (float*)(p.ws + OFF_T1);
    const int tid = threadIdx.x, lane = tid & 63, wave = tid >> 6;
    const int v = tid & 31, kg = tid >> 5;
    const int tl = tid >> 4, kc = (tid & 15) * 8;
    for (int item = blockIdx.x; item < 256; item += gridDim.x) {
        const int vs = item & 3, dir = (item >> 2) & 1, h = (item >> 3) & 7, b = item >> 6;
        float lbv[8];
#pragma unroll
        for (int e = 0; e < 8; ++e) { const float* lp = p.lb_logits + dir * 3072 + h * 128 + kc + e; const float l0 = lp[0], l1 = lp[1024], l2 = lp[2048];
            const float mx = fmaxf(l0, fmaxf(l1, l2)); const float e0 = expf(l0 - mx), e1 = expf(l1 - mx), e2 = expf(l2 - mx); lbv[e] = e0 / (e0 + e1 + e2); }
        float S[8];
#pragma unroll
        for (int e = 0; e < 8; ++e) S[e] = 0.f;
        float* Oout = OFB + (size_t)dir * MTOK * AW;
        for (int batch = 0; batch < 72; ++batch) {
            const int i0 = batch * 32; const bool isctx = i0 < CTXL;
            {
                const int i = i0 + tl;
                const bf16_t* rp;
                if (isctx) { const int tk = dir ? (CTXL - 1 - i) : i; rp = CPROJ + (size_t)(b * CTXL + tk) * NAB; }
                else { const int jj = i - CTXL; const int tk = dir ? (SEQ - 1 - jj) : jj; rp = PROJ + (size_t)(b * SEQ + tk) * NAB; }
                const u32x4v zz = *(const u32x4v*)(rp + dir * 1024 + h * 128 + kc);
                u32x4v qq = {0u, 0u, 0u, 0u};
                if (!isctx) qq = *(const u32x4v*)(rp + 3072 + h * 128 + kc);
#pragma unroll
                for (int e = 0; e < 4; ++e) {
                    const float z0 = __uint_as_float(zz[e] << 16), z1 = __uint_as_float(zz[e] & 0xffff0000u);
                    const float f0 = lbv[2 * e] + (1.f - lbv[2 * e]) * sigm(z0), f1 = lbv[2 * e + 1] + (1.f - lbv[2 * e + 1]) * sigm(z1);
                    Fb[tl * 128 + kc + 2 * e] = f0; Fb[tl * 128 + kc + 2 * e + 1] = f1;
                    Kb[tl * 128 + kc + 2 * e] = 1.f - f0; Kb[tl * 128 + kc + 2 * e + 1] = 1.f - f1;
                    Qb[tl * 128 + kc + 2 * e] = __uint_as_float(qq[e] << 16); Qb[tl * 128 + kc + 2 * e + 1] = __uint_as_float(qq[e] & 0xffff0000u); }
                if (tid < 128) { const int t2 = tid >> 2, vc = (tid & 3) * 8; const int i2 = i0 + t2;
                    const bf16_t* rp2;
                    if (isctx) { const int tk = dir ? (CTXL - 1 - i2) : i2; rp2 = CPROJ + (size_t)(b * CTXL + tk) * NAB; }
                    else { const int jj = i2 - CTXL; const int tk = dir ? (SEQ - 1 - jj) : jj; rp2 = PROJ + (size_t)(b * SEQ + tk) * NAB; }
                    const u32x4v vv = *(const u32x4v*)(rp2 + 2048 + h * 128 + vs * 32 + vc);
#pragma unroll
                    for (int e = 0; e < 4; ++e) { Vb[t2 * 32 + vc + 2 * e] = __uint_as_float(vv[e] << 16); Vb[t2 * 32 + vc + 2 * e + 1] = __uint_as_float(vv[e] & 0xffff0000u); } }
            }
            __syncthreads();
            for (int t = 0; t < 32; ++t) {
                const pg8::f32x4 f0 = *(const pg8::f32x4*)(Fb + t * 128 + kg * 8), f1 = *(const pg8::f32x4*)(Fb + t * 128 + kg * 8 + 4);
                const pg8::f32x4 k0 = *(const pg8::f32x4*)(Kb + t * 128 + kg * 8), k1 = *(const pg8::f32x4*)(Kb + t * 128 + kg * 8 + 4);
                const pg8::f32x4 q0 = *(const pg8::f32x4*)(Qb + t * 128 + kg * 8), q1 = *(const pg8::f32x4*)(Qb + t * 128 + kg * 8 + 4);
                const float vv = Vb[t * 32 + v];
                float o = 0.f;
#pragma unroll
                for (int e = 0; e < 4; ++e) { S[e] = f0[e] * S[e] + k0[e] * vv; o += S[e] * q0[e]; S[4 + e] = f1[e] * S[4 + e] + k1[e] * vv; o += S[4 + e] * q1[e]; }
                o += __shfl_xor(o, 32);
                if (lane < 32) Op[(t * 8 + wave) * 32 + v] = o;
            }
            __syncthreads();
            if (!isctx) {
#pragma unroll
                for (int r = 0; r < 2; ++r) { const int idx = tid + 512 * r, t = idx >> 5, vv = idx & 31;
                    float s = 0.f;
#pragma unroll
                    for (int w = 0; w < 8; ++w) s += Op[(t * 8 + w) * 32 + vv];
                    const int jj = i0 + t - CTXL; const int tk = dir ? (SEQ - 1 - jj) : jj;
                    Oout[(size_t)(b * SEQ + tk) * AW + h * 128 + vs * 32 + vv] = s; }
            }
        }
        __syncthreads();
    }
}
DEV void phase_readout(const Params& p) {
    const bf16_t* PROJ = (const bf16_t*)(p.ws + OFF_BIG);
    const float* OF = (const float*)(p.ws + OFF_T1); const float* OB = OF + (size_t)MTOK * AW;
    bf16_t* Y = (bf16_t*)(p.ws + OFF_Y);
    const int wave = threadIdx.x >> 6, lane = threadIdx.x & 63;
    const int gw = blockIdx.x * 8 + wave, NGW = gridDim.x * 8;
    for (int row = gw; row < MTOK; row += NGW) {
        const int c0 = lane * 16;
        float o[16]; float ss = 0.f;
#pragma unroll
        for (int j = 0; j < 4; ++j) { const pg8::f32x4 a = *(const pg8::f32x4*)(OF + (size_t)row * AW + c0 + 4 * j), bq = *(const pg8::f32x4*)(OB + (size_t)row * AW + c0 + 4 * j);
#pragma unroll
            for (int e = 0; e < 4; ++e) { o[4 * j + e] = a[e] + bq[e]; ss += o[4 * j + e] * o[4 * j + e]; } }
        ss += __shfl_xor(ss, 1); ss += __shfl_xor(ss, 2); ss += __shfl_xor(ss, 4);
        const float rstd = rsqrtf(ss * (1.f / DH) + EPS);
#pragma unroll
        for (int hh = 0; hh < 2; ++hh) {
            const u32x4v gg = *(const u32x4v*)(PROJ + (size_t)row * NAB + 4096 + c0 + 8 * hh);
            u32x4v w;
#pragma unroll
            for (int e = 0; e < 4; ++e) { const int ci = 8 * hh + 2 * e;
                const float g0 = __uint_as_float(gg[e] << 16), g1 = __uint_as_float(gg[e] & 0xffff0000u);
                w[e] = pk2(o[ci] * rstd * p.ab_gnorm_g[c0 + ci] * siluf(g0), o[ci + 1] * rstd * p.ab_gnorm_g[c0 + ci + 1] * siluf(g1)); }
            *(u32x4v*)(Y + (size_t)row * DM + c0 + 8 * hh) = w; }
    }
}
DEV void phase_hyprep(const Params& p, unsigned char* shm) {
    const bf16_t* P = (const bf16_t*)(p.ws + OFF_BIG);
    bf16_t* T2 = (bf16_t*)(p.ws + OFF_T2);
    const int wave = threadIdx.x >> 6, lane = threadIdx.x & 63;
    float* scr = (float*)shm + wave * (64 * 65);
    const int gw = blockIdx.x * 8 + wave, NGW = gridDim.x * 8;
    for (int it = gw; it < 128 * 96; it += NGW) {
        const int ct = it % 96, tt = it / 96, tok0 = tt * 64, c0 = ct * 64;
#pragma unroll 8
        for (int i = 0; i < 64; ++i) scr[i * 65 + lane] = bf2f(P[(size_t)(tok0 + i) * NHY + c0 + lane]);
        lds_fence();
        const int which = c0 >> 11;
        bf16_t* dst = T2 + (size_t)which * (2048 * 8192) + (size_t)(c0 - which * 2048) * 8192 + tok0 + lane;
        for (int cc = 0; cc < 64; ++cc) {
            const float w0 = p.hy_short_w[c0 + cc], w1 = p.hy_short_w[NHY + c0 + cc], w2 = p.hy_short_w[2 * NHY + c0 + cc];
            const float cen = scr[lane * 65 + cc];
            const float lf = lane > 0 ? scr[(lane - 1) * 65 + cc] : 0.f;
            const float rt = lane < 63 ? scr[(lane + 1) * 65 + cc] : 0.f;
            dst[(size_t)cc * 8192] = f2bf(w0 * lf + w1 * cen + w2 * rt);
        }
        lds_fence();
    }
    __syncthreads();
}
DEV void phase_longconv_naive(const Params& p, unsigned char* shm) {
    float* Tn = (float*)shm; float* Za = Tn + 4096; float* Zb = Za + 8192; float* red = Zb + 8192;
    bf16_t* T2 = (bf16_t*)(p.ws + OFF_T2);
    const float* TAPS = (const float*)(p.ws + OFF_T1);
    const int tid = threadIdx.x, lane = tid & 63, wave = tid >> 6;
    for (int d = blockIdx.x; d < DM; d += gridDim.x) {
        bf16_t* ZT = T2 + (size_t)2 * (2048 * 8192) + (size_t)d * 8192;
        const bf16_t* X1T = T2 + (size_t)d * 8192; const bf16_t* X2T = T2 + (size_t)(2048 * 8192) + (size_t)d * 8192;
        for (int idx = tid; idx < 8192; idx += 512) Za[idx] = bf2f(ZT[idx]);
        for (int o = 0; o < 2; ++o) {
            const float* T = TAPS + ((size_t)(o * 2048 + d)) * 4096;
            float tv[8]; float s = 0.f;
#pragma unroll
            for (int r = 0; r < 8; ++r) { tv[r] = T[tid + 512 * r]; s += fabsf(tv[r]); }
            s = wave_sum(s); if (lane == 0) red[wave] = s;
            __syncthreads();
            float tot = 0.f;
#pragma unroll
            for (int w = 0; w < 8; ++w) tot += red[w];
            const float inv = 1.f / tot;
#pragma unroll
            for (int r = 0; r < 8; ++r) Tn[tid + 512 * r] = tv[r] * inv;
            __syncthreads();
            const float* src = o == 0 ? Za : Zb; float* dst = o == 0 ? Zb : Za;
            float acc[4][4];
#pragma unroll
            for (int b = 0; b < 4; ++b)
#pragma unroll
                for (int j = 0; j < 4; ++j) acc[b][j] = 0.f;
            for (int si = 0; si < 512; ++si) {
                const int m0 = 4 * (tid - si) + 2048;
                const pg8::f32x4 lo = *(const pg8::f32x4*)(Tn + m0 - 4), hi = *(const pg8::f32x4*)(Tn + m0);
                float tw[8]; tw[0] = lo[0]; tw[1] = lo[1]; tw[2] = lo[2]; tw[3] = lo[3]; tw[4] = hi[0]; tw[5] = hi[1]; tw[6] = hi[2]; tw[7] = hi[3];
#pragma unroll
                for (int b = 0; b < 4; ++b) { const pg8::f32x4 zz = *(const pg8::f32x4*)(src + b * 2048 + 4 * si);
#pragma unroll
                    for (int j = 0; j < 4; ++j)
#pragma unroll
                        for (int i = 0; i < 4; ++i) acc[b][j] += tw[4 + j - i] * zz[i]; }
            }
            const float skip = p.skip[o * 2048 + d];
            const bf16_t* gate = o == 0 ? X1T : X2T;
            float res[4][4];
#pragma unroll
            for (int b = 0; b < 4; ++b)
#pragma unroll
                for (int j = 0; j < 4; ++j) { const int t = 4 * tid + j; res[b][j] = bf2f(gate[b * 2048 + t]) * (acc[b][j] + src[b * 2048 + t] * skip); }
#pragma unroll
            for (int b = 0; b < 4; ++b)
#pragma unroll
                for (int j = 0; j < 4; ++j) dst[b * 2048 + 4 * tid + j] = res[b][j];
            __syncthreads();
        }
        for (int idx = tid; idx < 8192; idx += 512) ZT[idx] = f2bf(Za[idx]);
        __syncthreads();
    }
}
DEV void phase_transback(const Params& p, unsigned char* shm) {
    const bf16_t* ZT = (const bf16_t*)(p.ws + OFF_T2) + (size_t)2 * (2048 * 8192);
    bf16_t* Y = (bf16_t*)(p.ws + OFF_Y);
    const int wave = threadIdx.x >> 6, lane = threadIdx.x & 63;
    unsigned short* scr = (unsigned short*)shm + wave * (64 * 66);
    const int gw = blockIdx.x * 8 + wave, NGW = gridDim.x * 8;
    for (int it = gw; it < 32 * 128; it += NGW) {
        const int ct = it & 31, tt = it >> 5, c0 = ct * 64, tok0 = tt * 64;
#pragma unroll 8
        for (int i = 0; i < 64; ++i) scr[i * 66 + lane] = ZT[(size_t)(c0 + i) * 8192 + tok0 + lane];
        lds_fence();
#pragma unroll 8
        for (int t = 0; t < 64; ++t) Y[(size_t)(tok0 + t) * DM + c0 + lane] = scr[lane * 66 + t];
        lds_fence();
    }
    __syncthreads();
}

enum { P_PREP = 0, P_NORM0, P_GEMM_IN, P_SCAN, P_READOUT, P_GEMM_OUT0, P_NORM0B, P_GEMM_UP0, P_GEMM_DN0, P_NORM1, P_GEMM_HYIN, P_HYPREP, P_LCONV, P_TRANSB,
       P_GEMM_OUT1, P_NORM1B, P_GEMM_UP1, P_GEMM_DN1, P_FINAL, NPHASE };

template <int KK, int NN, class Epi>
DEV void run_gemm(unsigned char* shm, const bf16_t* A, const bf16_t* Bt, const Epi& E, int exn, int expm0, int exnN) {
    pg8::Gemm g; g.A = A; g.Bt = Bt; g.M = MTOK; g.N = NN; g.K = KK;
    OrderX S; S.init(MTOK, NN, gridDim.x, blockIdx.x, exn, expm0, exnN);
    pg8::gemm_phase<Epi, OrderX, true, true>((PG8_LAS unsigned char*)shm, g, S, E);
}

__global__ __launch_bounds__(512, 2) void mega(Params p) {
    extern __shared__ __attribute__((aligned(16))) unsigned char shm[];
    cg::grid_group grid = cg::this_grid();
    const int lo = p.ph_lo, hi = p.ph_hi;
#ifndef KEEPMASK
#define KEEPMASK 0xFFFFFFFFu
#endif
#define IN(k) ((((KEEPMASK) >> (k)) & 1u) && lo <= (k) && (k) < hi)
#define SEAM(k) do { if (IN(k) && IN((k) + 1)) grid.sync(); } while (0)
#define WS(T, off) ((T*)(p.ws + (off)))
    if (IN(P_PREP)) {
#ifndef NO_ADA
        phase_ada(p, shm); __syncthreads();
#endif
#ifndef NO_HDN
        phase_hdn(p, shm); __syncthreads();
#endif
#ifndef NO_CONV
        phase_convert(p, shm);
#endif
    }
    SEAM(P_PREP);
    if (IN(P_NORM0)) {
        norm_rows(p.x, MTOK, SEQ, p.norm_g, WS(float, OFF_MOD), 12288, 0, DM, WS(bf16_t, OFF_H));
        norm_rows(p.ctx, MCTX, MCTX, p.norm_g, WS(float, OFF_MOD) + (size_t)4 * 12288, 0, 0, DM, WS(bf16_t, OFF_H) + (size_t)MTOK * DM);
    }
    SEAM(P_NORM0);
    if (IN(P_GEMM_IN)) { EpiBf16<0> E; E.O = WS(bf16_t, OFF_BIG); E.ldc = NAB; run_gemm<2048, NAB>(shm, WS(bf16_t, OFF_H), WS(bf16_t, OFF_WIN), E, 48, 32, 12); }
    SEAM(P_GEMM_IN);
    if (IN(P_SCAN)) { phase_convbranch(p); phase_scan_naive(p, shm); }
    SEAM(P_SCAN);
    if (IN(P_READOUT)) phase_readout(p);
    SEAM(P_READOUT);
    if (IN(P_GEMM_OUT0)) { EpiResid E; E.gstride = 12288; E.R = p.x; E.C = WS(float, OFF_X1); E.gate = WS(float, OFF_MOD) + 2 * DM;
        run_gemm<2048, DM>(shm, WS(bf16_t, OFF_Y), WS(bf16_t, OFF_WOUT), E, 0, 0, 1); }
    SEAM(P_GEMM_OUT0);
    if (IN(P_NORM0B)) norm_rows(WS(float, OFF_X1), MTOK, SEQ, p.norm_g + DM, WS(float, OFF_MOD), 12288, 3 * DM, 4 * DM, WS(bf16_t, OFF_H));
    SEAM(P_NORM0B);
    if (IN(P_GEMM_UP0)) { EpiBf16<1> E; E.O = WS(bf16_t, OFF_BIG); E.ldc = FF; run_gemm<2048, FF>(shm, WS(bf16_t, OFF_H), WS(bf16_t, OFF_W1_0), E, 0, 0, 1); }
    SEAM(P_GEMM_UP0);
    if (IN(P_GEMM_DN0)) { EpiResid E; E.gstride = 12288; E.R = WS(float, OFF_X1); E.C = WS(float, OFF_X2); E.gate = WS(float, OFF_MOD) + 5 * DM;
        run_gemm<8192, DM>(shm, WS(bf16_t, OFF_BIG), WS(bf16_t, OFF_W2_0), E, 0, 0, 1); }
    SEAM(P_GEMM_DN0);
    if (IN(P_NORM1)) { norm_rows(WS(float, OFF_X2), MTOK, SEQ, p.norm_g + 2 * DM, WS(float, OFF_MOD) + (size_t)5 * 12288, 12288, 0, DM, WS(bf16_t, OFF_H)); phase_taps(p); }
    SEAM(P_NORM1);
    if (IN(P_GEMM_HYIN)) { EpiBf16<0> E; E.O = WS(bf16_t, OFF_BIG); E.ldc = NHY; run_gemm<2048, NHY>(shm, WS(bf16_t, OFF_H), WS(bf16_t, OFF_HYIN), E, 0, 0, 1); }
    SEAM(P_GEMM_HYIN);
    if (IN(P_HYPREP)) phase_hyprep(p, shm);
    SEAM(P_HYPREP);
    if (IN(P_LCONV)) phase_longconv_naive(p, shm);
    SEAM(P_LCONV);
    if (IN(P_TRANSB)) phase_transback(p, shm);
    SEAM(P_TRANSB);
    if (IN(P_GEMM_OUT1)) { EpiResid E; E.gstride = 12288; E.R = WS(float, OFF_X2); E.C = WS(float, OFF_X1); E.gate = WS(float, OFF_MOD) + (size_t)5 * 12288 + 2 * DM;
        run_gemm<2048, DM>(shm, WS(bf16_t, OFF_Y), WS(bf16_t, OFF_HYOUT), E, 0, 0, 1); }
    SEAM(P_GEMM_OUT1);
    if (IN(P_NORM1B)) norm_rows(WS(float, OFF_X1), MTOK, SEQ, p.norm_g + 3 * DM, WS(float, OFF_MOD) + (size_t)5 * 12288, 12288, 3 * DM, 4 * DM, WS(bf16_t, OFF_H));
    SEAM(P_NORM1B);
    if (IN(P_GEMM_UP1)) { EpiBf16<1> E; E.O = WS(bf16_t, OFF_BIG); E.ldc = FF; run_gemm<2048, FF>(shm, WS(bf16_t, OFF_H), WS(bf16_t, OFF_W1_1), E, 0, 0, 1); }
    SEAM(P_GEMM_UP1);
    if (IN(P_GEMM_DN1)) { EpiResid E; E.gstride = 12288; E.R = WS(float, OFF_X1); E.C = WS(float, OFF_X2); E.gate = WS(float, OFF_MOD) + (size_t)5 * 12288 + 5 * DM;
        run_gemm<8192, DM>(shm, WS(bf16_t, OFF_BIG), WS(bf16_t, OFF_W2_1), E, 0, 0, 1); }
    SEAM(P_GEMM_DN1);
    if (IN(P_FINAL)) final_norm_rows(WS(float, OFF_X2), p.final_g, p.out);
#undef IN
#undef SEAM
#undef WS
}

extern "C" void kernel_launch(void* const* d_in, const int* in_sizes, int n_in, void* d_out, int out_size, void* d_ws, size_t ws_size, hipStream_t stream) {
    static int grid = 0;
    if (grid == 0) {
        if (n_in != 27 || ws_size < WS_END) { fprintf(stderr, "kernel_launch: unexpected n_in %d or workspace %zu < %zu\n", n_in, ws_size, (size_t)WS_END); grid = -1; return; }
        int dev = 0, cus = 0, per_cu = 0;
        hipGetDevice(&dev); hipDeviceGetAttribute(&cus, hipDeviceAttributeMultiprocessorCount, dev);
        if (hipFuncSetAttribute((const void*)mega, hipFuncAttributeMaxDynamicSharedMemorySize, LDS_BYTES) != hipSuccess) { fprintf(stderr, "kernel_launch: hipFuncSetAttribute failed\n"); grid = -1; return; }
        if (hipOccupancyMaxActiveBlocksPerMultiprocessor(&per_cu, (const void*)mega, 512, LDS_BYTES) != hipSuccess || per_cu < 1) { fprintf(stderr, "kernel_launch: occupancy query gave %d\n", per_cu); per_cu = 1; }
        (void)hipGetLastError();
        grid = cus * per_cu;
    }
    if (grid < 0) return;
    Params p{};
    const float** f = (const float**)&p;
    for (int i = 0; i < 27; ++i) f[i] = (const float*)d_in[i];
    p.out = (float*)d_out; p.ws = (unsigned char*)d_ws; p.ph_lo = 0; p.ph_hi = NPHASE;
    void* args[] = {&p};
    hipError_t e = hipLaunchCooperativeKernel((const void*)mega, dim3(grid), dim3(512), args, LDS_BYTES, stream);
    if (e != hipSuccess) fprintf(stderr, "cooperative launch failed: %s (grid %d)\n", hipGetErrorString(e), grid);
}
```

```cpp
#include <hip/hip_runtime.h>
#include <hip/hip_cooperative_groups.h>
#include <cstdio>
#include <cstdint>
namespace cg = cooperative_groups;
namespace pg8 {
#define PG8_LAS __attribute__((address_space(3)))
typedef unsigned short bf16_t;
typedef short bf16x8 __attribute__((ext_vector_type(8)));
typedef float f32x4 __attribute__((ext_vector_type(4)));
typedef unsigned u32x4 __attribute__((ext_vector_type(4)));
constexpr int BM = 256, BK = 64, HALF = 128, HTB = HALF * BK * 2  , STAGE_BYTES = 8 * HTB, NXCD = 8, WGM = 8;

__host__ __device__ __forceinline__ int lds_byte(int r, int c) { const int st = (r >> 4) * 2 + (c >> 5), rr = r & 15, cc = c & 31, ob = rr * 64 + cc * 2; return st * 1024 + (ob ^ (((ob >> 9) & 1) << 5)); }
__host__ __device__ __forceinline__ void stage_rc(int b, int& R, int& C) { const int st = b / 1024, sb = b % 1024, swz = sb ^ (((sb >> 9) & 1) << 5); R = (st >> 1) * 16 + swz / 64; C = (st & 1) * 32 + (swz % 64) / 2; }
__host__ __device__ __forceinline__ int perm32(int rho) { const int n = rho >> 4, i = rho & 15; return 8 * (i >> 2) + 4 * n + (i & 3); }

struct Unit { int pm, pn; };
struct Gemm { const bf16_t* A; const bf16_t* Bt; int M, N, K; };

struct StaticOrder {
    int nM, nN, nwg, G, c;
    __host__ __device__ void init(int M, int N, int G_, int c_) { nM = M / BM; nN = N / BM; nwg = nM * nN; G = G_; c = c_; }
    __host__ __device__ bool next(int i, Unit& u) const {
        const long L = (long)i * G + c; if (L >= nwg) return false;
        int wgid = (int)L; { const int q = nwg / NXCD, r = nwg % NXCD, xcd = wgid % NXCD, off = wgid / NXCD; wgid = (xcd < r ? xcd * (q + 1) : r * (q + 1) + (xcd - r) * q) + off; }
        const int nig = WGM * nN, gid = wgid / nig, fm = gid * WGM, gsz = (nM - fm) < WGM ? (nM - fm) : WGM;
        u.pm = fm + ((wgid % nig) % gsz); u.pn = (wgid % nig) / gsz; return true;
    }
    __device__ __forceinline__ void a_ready(const Unit&) const {}
    __device__ __forceinline__ void done(const Unit&) const {}
};
__device__ __forceinline__ unsigned cvt_pk_bf16(float lo, float hi) { unsigned r; asm volatile("v_cvt_pk_bf16_f32 %0, %1, %2" : "=v"(r) : "v"(lo), "v"(hi)); return r; }
template <class Epi, class Sched, bool ALIGN_EPI = false, bool SP2 = false>
__device__ __forceinline__ void gemm_phase(PG8_LAS unsigned char* lds, const Gemm g, const Sched& S, const Epi& E) {
    const int tid = threadIdx.x, wid = __builtin_amdgcn_readfirstlane(tid >> 6), lane = tid & 63, wr = wid >> 2, wc = wid & 3, fr = lane & 15, fq = lane >> 4;
    const int K = g.K, nt = K / BK;
    unsigned voffA[2], voffB[2];
#pragma unroll
    for (int i = 0; i < 2; ++i) { int R, C; stage_rc(tid * 16 + i * 8192, R, C); const int Rb = Epi::PERM ? ((R & ~31) + perm32(R & 31)) : R;
        voffA[i] = (unsigned)(R * K + C) * 2u; voffB[i] = (unsigned)(Rb * K + C) * 2u; }
    const size_t kstep = (size_t)(BK * 2);
    const size_t hstep = (size_t)HALF * K * 2;
    const size_t tstep = 2 * hstep;
    const unsigned ldsw = (unsigned)wid * 1024u;
    const int aoff = lds_byte(wr * 64 + fr, fq * 8), boff = lds_byte(wc * 32 + fr, fq * 8);
#define PG8_SA(b, h) (((b) * 2 + (h)) * HTB)
#define PG8_SB(b, h) ((4 + (b) * 2 + (h)) * HTB)
#define PG8_STAGE(bufoff, gbase, voff) do { _Pragma("unroll") for (int _i = 0; _i < 2; ++_i) \
        __builtin_amdgcn_global_load_lds((const unsigned*)((const char*)(gbase) + (voff)[_i]), (PG8_LAS unsigned*)(lds + (bufoff) + ldsw + _i * 8192), 16, 0, 0); } while (0)
#define PG8_LDA(dst, b, h) do { _Pragma("unroll") for (int m = 0; m < 4; ++m) _Pragma("unroll") for (int k = 0; k < 2; ++k) dst[m][k] = *(const PG8_LAS bf16x8*)(lds + PG8_SA(b, h) + aoff + m * 2048 + k * 1024); } while (0)
#define PG8_LDB(dst, b, h) do { _Pragma("unroll") for (int n = 0; n < 2; ++n) _Pragma("unroll") for (int k = 0; k < 2; ++k) dst[n][k] = *(const PG8_LAS bf16x8*)(lds + PG8_SB(b, h) + boff + n * 2048 + k * 1024); } while (0)
#define PG8_MMA(ai, bj, At, Bt) do { __builtin_amdgcn_s_setprio(1); _Pragma("unroll") for (int m = 0; m < 4; ++m) _Pragma("unroll") for (int n = 0; n < 2; ++n) _Pragma("unroll") for (int k = 0; k < 2; ++k) \
        acc[ai][bj][m][n] = __builtin_amdgcn_mfma_f32_16x16x32_bf16(Bt[n][k], At[m][k], acc[ai][bj][m][n], 0, 0, 0); __builtin_amdgcn_s_setprio(0); } while (0)
#define PG8_WAIT_V(n) asm volatile("s_waitcnt vmcnt(" #n ")" ::: "memory")
#define PG8_WAIT_L(n) asm volatile("s_waitcnt lgkmcnt(" #n ")" ::: "memory")
#define PG8_BAR __builtin_amdgcn_s_barrier()
#define PG8_SCHED __builtin_amdgcn_sched_barrier(0)
    Unit cur, nxt; int ui = 0;
    if (!S.next(0, cur)) return;
    f32x4 acc[2][2][4][2];
#pragma unroll
    for (int a = 0; a < 2; ++a)
#pragma unroll
        for (int b = 0; b < 2; ++b)
#pragma unroll
            for (int m = 0; m < 4; ++m)
#pragma unroll
                for (int n = 0; n < 2; ++n) acc[a][b][m][n] = (f32x4){0.f, 0.f, 0.f, 0.f};
    bf16x8 At[4][2], B0[2][2], B1[2][2];
    const char* cA = (const char*)g.A + (size_t)cur.pm * tstep; const char* cB = (const char*)g.Bt + (size_t)cur.pn * tstep;
    S.a_ready(cur);
    if constexpr (SP2) {
        PG8_STAGE(PG8_SB(0, 0), cB, voffB); PG8_STAGE(PG8_SB(0, 1), cB + hstep, voffB); PG8_STAGE(PG8_SA(0, 0), cA, voffA); PG8_STAGE(PG8_SA(0, 1), cA + hstep, voffA);
        if (wr == 1) PG8_BAR;
        PG8_WAIT_V(2); PG8_BAR;
        PG8_STAGE(PG8_SB(1, 0), cB + kstep, voffB); PG8_STAGE(PG8_SA(1, 0), cA + kstep, voffA); PG8_STAGE(PG8_SB(1, 1), cB + hstep + kstep, voffB);
        PG8_WAIT_V(6); PG8_BAR;
    } else {
        PG8_STAGE(PG8_SB(0, 0), cB, voffB); PG8_STAGE(PG8_SA(0, 0), cA, voffA); PG8_STAGE(PG8_SB(0, 1), cB + hstep, voffB); PG8_STAGE(PG8_SA(0, 1), cA + hstep, voffA);
        if (wr == 1) PG8_BAR;
        PG8_WAIT_V(4); PG8_BAR;
        PG8_STAGE(PG8_SB(1, 0), cB + kstep, voffB); PG8_STAGE(PG8_SA(1, 0), cA + kstep, voffA); PG8_STAGE(PG8_SB(1, 1), cB + hstep + kstep, voffB);
        PG8_WAIT_V(6); PG8_BAR;
    }
    for (;;) {
        const bool has_next = S.next(ui + 1, nxt);
        const char* nA = has_next ? (const char*)g.A + (size_t)nxt.pm * tstep : cA; const char* nB = has_next ? (const char*)g.Bt + (size_t)nxt.pn * tstep : cB;
        for (int t = 0; t < nt; t += 2) {
            const bool last = (t == nt - 2);
            const char* a1 = cA + (size_t)(t + 1) * kstep;
            const char* a2 = last ? nA : cA + (size_t)(t + 2) * kstep; const char* b2 = last ? nB : cB + (size_t)(t + 2) * kstep;
            const char* a3 = a2 + kstep; const char* b3 = b2 + kstep;
            if (last && has_next) S.a_ready(nxt);
            if constexpr (SP2) {
            PG8_LDB(B0, 0, 0); PG8_LDB(B1, 0, 1); PG8_SCHED; PG8_LDA(At, 0, 0); PG8_STAGE(PG8_SA(1, 1), a1 + hstep, voffA);
            PG8_WAIT_V(8); PG8_WAIT_L(0); PG8_BAR; PG8_MMA(0, 0, At, B0); PG8_MMA(0, 1, At, B1); PG8_BAR; PG8_SCHED;
            PG8_LDA(At, 0, 1); PG8_STAGE(PG8_SB(0, 0), b2, voffB); PG8_STAGE(PG8_SB(0, 1), b2 + hstep, voffB); PG8_STAGE(PG8_SA(0, 0), a2, voffA);
            PG8_WAIT_V(8); PG8_WAIT_L(0); PG8_BAR; PG8_MMA(1, 0, At, B0); PG8_MMA(1, 1, At, B1); PG8_BAR; PG8_SCHED;
            PG8_LDB(B0, 1, 0); PG8_LDB(B1, 1, 1); PG8_SCHED; PG8_LDA(At, 1, 0); PG8_STAGE(PG8_SA(0, 1), a2 + hstep, voffA);
            PG8_WAIT_V(8); PG8_WAIT_L(0); PG8_BAR; PG8_MMA(0, 0, At, B0); PG8_MMA(0, 1, At, B1); PG8_BAR; PG8_SCHED;
            PG8_LDA(At, 1, 1); PG8_STAGE(PG8_SB(1, 0), b3, voffB); PG8_STAGE(PG8_SB(1, 1), b3 + hstep, voffB); PG8_STAGE(PG8_SA(1, 0), a3, voffA);
            PG8_WAIT_V(8); PG8_WAIT_L(0); PG8_BAR; PG8_MMA(1, 0, At, B0); PG8_MMA(1, 1, At, B1); PG8_BAR; PG8_SCHED;
            } else {
            PG8_LDB(B0, 0, 0); PG8_SCHED; PG8_LDA(At, 0, 0); PG8_STAGE(PG8_SA(1, 1), a1 + hstep, voffA);
            PG8_WAIT_L(8); PG8_BAR; PG8_WAIT_L(0); PG8_MMA(0, 0, At, B0); PG8_BAR; PG8_SCHED;
            PG8_LDB(B1, 0, 1); PG8_STAGE(PG8_SB(0, 0), b2, voffB);
            PG8_BAR; PG8_WAIT_L(0); PG8_MMA(0, 1, At, B1); PG8_BAR;
            PG8_LDA(At, 0, 1); PG8_STAGE(PG8_SA(0, 0), a2, voffA);
            PG8_BAR; PG8_WAIT_L(0); PG8_MMA(1, 0, At, B0); PG8_BAR; PG8_SCHED;
            PG8_STAGE(PG8_SB(0, 1), b2 + hstep, voffB);
            PG8_WAIT_V(6); PG8_BAR; PG8_MMA(1, 1, At, B1); PG8_BAR;
            PG8_LDB(B0, 1, 0); PG8_SCHED; PG8_LDA(At, 1, 0); PG8_STAGE(PG8_SA(0, 1), a2 + hstep, voffA);
            PG8_WAIT_L(8); PG8_BAR; PG8_WAIT_L(0); PG8_MMA(0, 0, At, B0); PG8_BAR; PG8_SCHED;
            PG8_LDB(B1, 1, 1); PG8_STAGE(PG8_SB(1, 0), b3, voffB);
            PG8_BAR; PG8_WAIT_L(0); PG8_MMA(0, 1, At, B1); PG8_BAR;
            PG8_LDA(At, 1, 1); PG8_STAGE(PG8_SA(1, 0), a3, voffA);
            PG8_BAR; PG8_WAIT_L(0); PG8_MMA(1, 0, At, B0); PG8_BAR; PG8_SCHED;
            PG8_STAGE(PG8_SB(1, 1), b3 + hstep, voffB);
            PG8_WAIT_V(6); PG8_BAR; PG8_MMA(1, 1, At, B1); PG8_BAR;
            }
        }
        if constexpr (ALIGN_EPI) { if (wr == 0) PG8_BAR; }
        if constexpr (!Epi::AFTER_DRAIN) { E(acc, cur, wr, wc, fr, fq); S.done(cur); }
        if (!has_next) break;
#pragma unroll
        for (int a = 0; a < 2; ++a)
#pragma unroll
            for (int b = 0; b < 2; ++b)
#pragma unroll
                for (int m = 0; m < 4; ++m)
#pragma unroll
                    for (int n = 0; n < 2; ++n) acc[a][b][m][n] = (f32x4){0.f, 0.f, 0.f, 0.f};
        cur = nxt; cA = nA; cB = nB; ++ui;
        if constexpr (ALIGN_EPI) { if (wr == 1) PG8_BAR; }
    }
    PG8_WAIT_V(0);
    if constexpr (!ALIGN_EPI) { if (wr == 0) PG8_BAR; }
    PG8_BAR;
    if constexpr (Epi::AFTER_DRAIN) { E.fused(acc, cur, wr, wc, fr, fq, lds, wid, lane); S.done(cur); }
#undef PG8_SA
#undef PG8_SB
#undef PG8_STAGE
#undef PG8_LDA
#undef PG8_LDB
#undef PG8_MMA
#undef PG8_WAIT_V
#undef PG8_WAIT_L
#undef PG8_BAR
#undef PG8_SCHED
}
}
typedef unsigned short bf16_t;
#define DEV __device__ __forceinline__
constexpr int DM = 2048, NB = 4, SEQ = 2048, MTOK = NB * SEQ, CTXL = 256, MCTX = NB * CTXL, FF = 8192, AW = 1024, NH = 8, DH = 128;
constexpr int NAB = 8192, NHY = 6144;
constexpr float EPS = 1e-6f;
constexpr int LDS_BYTES = 163840;
constexpr size_t SZ_W8K = (size_t)8192 * 2048 * 2, SZ_W2K = (size_t)2048 * 2048 * 2;
constexpr size_t OFF_WIN = 0, OFF_WOUT = OFF_WIN + SZ_W8K, OFF_W1_0 = OFF_WOUT + SZ_W2K, OFF_W2_0 = OFF_W1_0 + SZ_W8K, OFF_HYIN = OFF_W2_0 + SZ_W8K,
                 OFF_HYOUT = OFF_HYIN + (size_t)6144 * 2048 * 2, OFF_W1_1 = OFF_HYOUT + SZ_W2K, OFF_W2_1 = OFF_W1_1 + SZ_W8K, OFF_MOD = OFF_W2_1 + SZ_W8K,
                 OFF_HDN = OFF_MOD + 524288, OFF_H = OFF_HDN + 524288, OFF_BIG = OFF_H + (size_t)9216 * 2048 * 2, OFF_Y = OFF_BIG + (size_t)9216 * 8192 * 2,
                 OFF_X1 = OFF_Y + (size_t)8192 * 2048 * 2, OFF_X2 = OFF_X1 + (size_t)8192 * 2048 * 4, OFF_T1 = OFF_X2 + (size_t)8192 * 2048 * 4,
                 OFF_T2 = OFF_T1 + (size_t)67108864, WS_END = OFF_T2 + (size_t)3 * 33554432;

struct Params {
    const float *x, *c, *ctx, *c_ctx, *ada_w, *ada_b, *norm_g, *lb_logits, *ab_w_in, *ab_conv_w, *ab_gnorm_g, *ab_w_out, *hy_in_w, *hy_short_w, *hy_out_w,
        *fw1, *fb1, *fw2, *fb2, *fw3, *fb3, *fw4, *freq, *skip, *w1, *w2, *final_g;
    float* out; unsigned char* ws; int ph_lo, ph_hi;
};

DEV float bf2f(bf16_t b) { return __uint_as_float(((unsigned)b) << 16); }
DEV unsigned pk2(float lo, float hi) { return pg8::cvt_pk_bf16(lo, hi); }
DEV bf16_t f2bf(float v) { return (bf16_t)(pk2(v, 0.f) & 0xffffu); }
DEV float wave_sum(float v) {
#pragma unroll
    for (int o = 1; o < 64; o <<= 1) v += __shfl_xor(v, o);
    return v;
}
DEV float sigm(float x) { return 1.f / (1.f + __expf(-x)); }
DEV float siluf(float x) { return x / (1.f + __expf(-x)); }
DEV void lds_fence() { asm volatile("s_waitcnt lgkmcnt(0)" ::: "memory"); __builtin_amdgcn_wave_barrier(); }

typedef unsigned u32x4v __attribute__((ext_vector_type(4)));
template <int ACT> struct EpiBf16 {
    static constexpr bool PERM = true, AFTER_DRAIN = false;
    bf16_t* O; int ldc;
    __device__ __forceinline__ void operator()(const pg8::f32x4 (&acc)[2][2][4][2], const pg8::Unit& u, int wr, int wc, int fr, int fq) const {
        const int row0 = u.pm * 256 + wr * 64 + fr, col0 = u.pn * 256 + wc * 32 + 8 * fq;
#pragma unroll
        for (int ai = 0; ai < 2; ++ai)
#pragma unroll
            for (int m = 0; m < 4; ++m) { bf16_t* rowp = O + (size_t)(row0 + ai * 128 + m * 16) * ldc + col0;
#pragma unroll
                for (int bj = 0; bj < 2; ++bj) { pg8::f32x4 v0 = acc[ai][bj][m][0], v1 = acc[ai][bj][m][1];
                    if (ACT == 1) {
#pragma unroll
                        for (int e = 0; e < 4; ++e) { float a = fmaxf(v0[e], 0.f), b = fmaxf(v1[e], 0.f); v0[e] = a * a; v1[e] = b * b; } }
                    u32x4v w; w.x = pk2(v0[0], v0[1]); w.y = pk2(v0[2], v0[3]); w.z = pk2(v1[0], v1[1]); w.w = pk2(v1[2], v1[3]);
                    *(u32x4v*)(rowp + bj * 128) = w; } }
    }
};
struct EpiResid {
    static constexpr bool PERM = false, AFTER_DRAIN = false;
    float* C; const float* R; const float* gate; int gstride;
    __device__ __forceinline__ void operator()(const pg8::f32x4 (&acc)[2][2][4][2], const pg8::Unit& u, int wr, int wc, int fr, int fq) const {
        const int row0 = u.pm * 256 + wr * 64 + fr, col0 = u.pn * 256 + wc * 32 + 4 * fq;
        const float* gp = gate + (size_t)((u.pm * 256) >> 11) * gstride + col0;
        pg8::f32x4 gv[2][2];
#pragma unroll
        for (int bj = 0; bj < 2; ++bj)
#pragma unroll
            for (int n = 0; n < 2; ++n) gv[bj][n] = *(const pg8::f32x4*)(gp + bj * 128 + n * 16);
#pragma unroll
        for (int ai = 0; ai < 2; ++ai)
#pragma unroll
            for (int m = 0; m < 4; ++m) { const size_t ro = (size_t)(row0 + ai * 128 + m * 16) * DM + col0;
#pragma unroll
                for (int bj = 0; bj < 2; ++bj)
#pragma unroll
                    for (int n = 0; n < 2; ++n) { const pg8::f32x4 r = *(const pg8::f32x4*)(R + ro + bj * 128 + n * 16);
                        *(pg8::f32x4*)(C + ro + bj * 128 + n * 16) = r + gv[bj][n] * acc[ai][bj][m][n]; } }
    }
};
struct OrderX {
    int nM, nN, nwg, G, c, ex_n, ex_pm0, ex_nN;
    __device__ void init(int M, int N, int G_, int c_, int exn, int expm0, int exnN) { nM = M / 256; nN = N / 256; nwg = nM * nN; G = G_; c = c_; ex_n = exn; ex_pm0 = expm0; ex_nN = exnN; }
    __device__ bool next(int i, pg8::Unit& u) const {
        const long L = (long)i * G + c; if (L >= nwg + ex_n) return false;
        if (L >= nwg) { const int e = (int)L - nwg; u.pm = ex_pm0 + e / ex_nN; u.pn = e % ex_nN; return true; }
        int wgid = (int)L; { const int q = nwg / 8, r = nwg % 8, xcd = wgid % 8, off = wgid / 8; wgid = (xcd < r ? xcd * (q + 1) : r * (q + 1) + (xcd - r) * q) + off; }
        const int nig = 8 * nN, gid = wgid / nig, fm = gid * 8, gsz = (nM - fm) < 8 ? (nM - fm) : 8;
        u.pm = fm + ((wgid % nig) % gsz); u.pn = (wgid % nig) / gsz; return true;
    }
    __device__ __forceinline__ void a_ready(const pg8::Unit&) const {}
    __device__ __forceinline__ void done(const pg8::Unit&) const {}
};

DEV void transpose_item(const float* __restrict__ W, int K, int N, bf16_t* __restrict__ WT, float* scr, int item, int lane) {
    const int nblk = N / 32, kb = item / nblk, nb = item % nblk, k0 = 64 * kb, n0 = 32 * nb;
#pragma unroll 8
    for (int i = 0; i < 32; ++i) { const int kk = 2 * i + (lane >> 5); scr[kk * 33 + (lane & 31)] = W[(size_t)(k0 + kk) * N + n0 + (lane & 31)]; }
    lds_fence();
    const int c = lane & 7;
#pragma unroll
    for (int j = 0; j < 4; ++j) { const int n = (lane >> 3) + 8 * j; const float* s = scr + (8 * c) * 33 + n;
        u32x4v o; o.x = pk2(s[0], s[33]); o.y = pk2(s[2 * 33], s[3 * 33]); o.z = pk2(s[4 * 33], s[5 * 33]); o.w = pk2(s[6 * 33], s[7 * 33]);
        *(u32x4v*)(WT + (size_t)(n0 + n) * K + k0 + 8 * c) = o; }
    lds_fence();
}
DEV void phase_convert(const Params& p, unsigned char* shm) {
    const int wave = threadIdx.x >> 6, lane = threadIdx.x & 63;
    float* scr = (float*)shm + wave * (64 * 33);
    const int gw = blockIdx.x * 8 + wave, NGW = gridDim.x * 8;
    constexpr int I8 = 32 * 256, I2 = 32 * 64, I6 = 32 * 192, IW2 = 128 * 64;
    constexpr int NIT = I8 + I2 + I8 + IW2 + I6 + I2 + I8 + IW2;
    for (int it = gw; it < NIT; it += NGW) {
        int r = it;
        if (r < I8) { transpose_item(p.ab_w_in, 2048, 8192, (bf16_t*)(p.ws + OFF_WIN), scr, r, lane); continue; } r -= I8;
        if (r < I2) { transpose_item(p.ab_w_out, 2048, 2048, (bf16_t*)(p.ws + OFF_WOUT), scr, r, lane); continue; } r -= I2;
        if (r < I8) { transpose_item(p.w1, 2048, 8192, (bf16_t*)(p.ws + OFF_W1_0), scr, r, lane); continue; } r -= I8;
        if (r < IW2) { transpose_item(p.w2, 8192, 2048, (bf16_t*)(p.ws + OFF_W2_0), scr, r, lane); continue; } r -= IW2;
        if (r < I6) { transpose_item(p.hy_in_w, 2048, 6144, (bf16_t*)(p.ws + OFF_HYIN), scr, r, lane); continue; } r -= I6;
        if (r < I2) { transpose_item(p.hy_out_w, 2048, 2048, (bf16_t*)(p.ws + OFF_HYOUT), scr, r, lane); continue; } r -= I2;
        if (r < I8) { transpose_item(p.w1 + (size_t)2048 * 8192, 2048, 8192, (bf16_t*)(p.ws + OFF_W1_1), scr, r, lane); continue; } r -= I8;
        transpose_item(p.w2 + (size_t)8192 * 2048, 8192, 2048, (bf16_t*)(p.ws + OFF_W2_1), scr, r, lane);
    }
    __syncthreads();
}
DEV void phase_ada(const Params& p, unsigned char* shm) {
    float* sil = (float*)shm;
    float* red = sil + 5 * 2080;
    const int tid = threadIdx.x;
    for (int i = tid; i < 5 * 2048; i += 512) { const int m = i >> 11, k = i & 2047; const float v = m < 4 ? p.c[m * 2048 + k] : p.c_ctx[k]; sil[m * 2080 + k + (k >> 6)] = siluf(v); }
    __syncthreads();
    float* MOD = (float*)(p.ws + OFF_MOD);
    const int cq = tid & 15, kg = tid >> 4;
    for (int u = blockIdx.x; u < 384; u += gridDim.x) {
        const int l = u / 192, n0 = (u % 192) * 64;
        float acc[5][4];
#pragma unroll
        for (int m = 0; m < 5; ++m)
#pragma unroll
            for (int e = 0; e < 4; ++e) acc[m][e] = 0.f;
        const float* wp = p.ada_w + ((size_t)l * 2048 + kg * 64) * 12288 + n0 + cq * 4;
#pragma unroll 4
        for (int k = 0; k < 64; ++k) { const pg8::f32x4 w = *(const pg8::f32x4*)(wp + (size_t)k * 12288);
#pragma unroll
            for (int m = 0; m < 5; ++m) { const float s = sil[m * 2080 + kg * 65 + k];
#pragma unroll
                for (int e = 0; e < 4; ++e) acc[m][e] += s * w[e]; } }
#pragma unroll
        for (int m = 0; m < 5; ++m)
#pragma unroll
            for (int e = 0; e < 4; ++e) red[(kg * 5 + m) * 64 + cq * 4 + e] = acc[m][e];
        __syncthreads();
        if (tid < 320) { const int m = tid >> 6, n = tid & 63; float s = p.ada_b[l * 12288 + n0 + n];
            for (int g = 0; g < 32; ++g) s += red[(g * 5 + m) * 64 + n];
            MOD[((size_t)l * 5 + m) * 12288 + n0 + n] = s; }
        __syncthreads();
    }
}
DEV void phase_hdn(const Params& p, unsigned char* shm) {
    float* zb = (float*)shm; float* ha = zb + 512; float* hb = ha + 512;
    float* HDN = (float*)(p.ws + OFF_HDN);
    const int tid = threadIdx.x, pl = tid >> 6, j = tid & 63;
    for (int pb = blockIdx.x; pb < 256; pb += gridDim.x) {
        const int pos = pb * 8 + pl;
        if (j < 33) { float val;
            if (j == 0) val = (float)pos / 2047.f;
            else { const int bi = (j - 1) & 15; const float band = 1e-4f + (float)bi * ((15.f - 1e-4f) / 15.f); const float w = 6.283185307179586f * (float)pos / 2048.f; const float ang = w * band;
                val = (j <= 16) ? cosf(ang) : -sinf(ang); }
            zb[pl * 64 + j] = val; }
        __syncthreads();
        const float fq = p.freq[j];
        float a = p.fb1[j];
#pragma unroll 3
        for (int i = 0; i < 33; ++i) a += zb[pl * 64 + i] * p.fw1[i * 64 + j];
        ha[pl * 64 + j] = sinf(fq * a);
        __syncthreads();
        a = p.fb2[j];
#pragma unroll 4
        for (int i = 0; i < 64; ++i) a += ha[pl * 64 + i] * p.fw2[i * 64 + j];
        hb[pl * 64 + j] = sinf(fq * a);
        __syncthreads();
        a = p.fb3[j];
#pragma unroll 4
        for (int i = 0; i < 64; ++i) a += hb[pl * 64 + i] * p.fw3[i * 64 + j];
        HDN[pos * 64 + j] = sinf(fq * a);
        __syncthreads();
    }
}
DEV void phase_taps(const Params& p) {
    const float* HDN = (const float*)(p.ws + OFF_HDN);
    float* TAPS = (float*)(p.ws + OFF_T1);
    const int lane = threadIdx.x & 63, wv = __builtin_amdgcn_readfirstlane(threadIdx.x >> 6);
    const float min_decay = -3.0701134573253943f, max_decay = -15.350567286626972f;
    for (int unit = blockIdx.x; unit < 2048; unit += gridDim.x) {
        const int pt = unit & 31, dt = (unit >> 5) & 31, o = unit >> 10;
        const int pos = pt * 64 + lane;
        float hd[64];
#pragma unroll
        for (int j = 0; j < 16; ++j) { const pg8::f32x4 v = *(const pg8::f32x4*)(HDN + pos * 64 + 4 * j); hd[4 * j] = v[0]; hd[4 * j + 1] = v[1]; hd[4 * j + 2] = v[2]; hd[4 * j + 3] = v[3]; }
        const float tt = (float)pos / 2047.f;
        for (int cc = 0; cc < 8; ++cc) {
            const int d = dt * 64 + wv * 8 + cc;
            const float* f4 = p.fw4 + o * 4096 + d;
            float af = 0.f, ab = 0.f;
#pragma unroll
            for (int j = 0; j < 64; ++j) { af += hd[j] * f4[j * 8192]; ab += hd[j] * f4[j * 8192 + 2048]; }
            const float delta = fabsf(min_decay + (float)d * ((max_decay - min_decay) / 2047.f));
            const float win = expf(-tt * delta);
            af *= win; ab *= win;
            float* T = TAPS + ((size_t)(o * 2048 + d)) * 4096;
            if (pos == 0) { T[2048] = af + ab; T[0] = 0.f; } else { T[2048 + pos] = af; T[2048 - pos] = ab; }
        }
    }
}
DEV void norm_rows(const float* __restrict__ X, int nrows, int rows_per_batch, const float* __restrict__ g, const float* __restrict__ mod, int mstride, int sh_off, int sc_off, bf16_t* __restrict__ O) {
    const int wave = threadIdx.x >> 6, lane = threadIdx.x & 63;
    const int gw = blockIdx.x * 8 + wave, NGW = gridDim.x * 8;
    for (int row = gw; row < nrows; row += NGW) {
        const pg8::f32x4* xr = (const pg8::f32x4*)(X + (size_t)row * DM) + lane;
        pg8::f32x4 v[8]; float s = 0.f;
#pragma unroll
        for (int j = 0; j < 8; ++j) { v[j] = xr[64 * j]; s += (v[j][0] * v[j][0] + v[j][1] * v[j][1]) + (v[j][2] * v[j][2] + v[j][3] * v[j][3]); }
        const float rstd = rsqrtf(wave_sum(s) * (1.f / DM) + EPS);
        const float* mb = mod + (size_t)(row / rows_per_batch) * mstride;
        unsigned long long* o8 = (unsigned long long*)(O + (size_t)row * DM) + lane;
#pragma unroll
        for (int j = 0; j < 8; ++j) { const int cidx = 4 * (lane + 64 * j);
            const pg8::f32x4 gg = *(const pg8::f32x4*)(g + cidx), sh = *(const pg8::f32x4*)(mb + sh_off + cidx), sc = *(const pg8::f32x4*)(mb + sc_off + cidx);
            float r[4];
#pragma unroll
            for (int e = 0; e < 4; ++e) r[e] = v[j][e] * rstd * gg[e] * (1.f + sc[e]) + sh[e];
            o8[64 * j] = (unsigned long long)pk2(r[0], r[1]) | ((unsigned long long)pk2(r[2], r[3]) << 32); }
    }
}
DEV void final_norm_rows(const float* __restrict__ X, const float* __restrict__ g, float* __restrict__ O) {
    const int wave = threadIdx.x >> 6, lane = threadIdx.x & 63;
    const int gw = blockIdx.x * 8 + wave, NGW = gridDim.x * 8;
    for (int row = gw; row < MTOK; row += NGW) {
        const pg8::f32x4* xr = (const pg8::f32x4*)(X + (size_t)row * DM) + lane;
        pg8::f32x4 v[8]; float s = 0.f;
#pragma unroll
        for (int j = 0; j < 8; ++j) { v[j] = xr[64 * j]; s += (v[j][0] * v[j][0] + v[j][1] * v[j][1]) + (v[j][2] * v[j][2] + v[j][3] * v[j][3]); }
        const float rstd = rsqrtf(wave_sum(s) * (1.f / DM) + EPS);
        pg8::f32x4* orow = (pg8::f32x4*)(O + (size_t)row * DM) + lane;
#pragma unroll
        for (int j = 0; j < 8; ++j) { const pg8::f32x4 gg = *(const pg8::f32x4*)(g + 4 * (lane + 64 * j)); orow[64 * j] = v[j] * rstd * gg; }
    }
}
DEV void phase_convbranch(const Params& p) {
    const bf16_t* PROJ = (const bf16_t*)(p.ws + OFF_BIG);
    bf16_t* Y = (bf16_t*)(p.ws + OFF_Y);
    for (int item = blockIdx.x * 512 + threadIdx.x; item < MTOK * 128; item += gridDim.x * 512) {
        const int row = item >> 7, c = (item & 127) * 8, t = row & 63;
        float acc[8];
#pragma unroll
        for (int e = 0; e < 8; ++e) acc[e] = 0.f;
#pragma unroll
        for (int dt = -1; dt <= 1; ++dt) {
            if ((dt < 0 && t == 0) || (dt > 0 && t == 63)) continue;
            const bf16_t* rp = PROJ + (size_t)(row + dt) * NAB;
            const u32x4v uu = *(const u32x4v*)(rp + 5120 + c), gc = *(const u32x4v*)(rp + 7168 + c);
            const float* w = p.ab_conv_w + (dt + 1) * 1024 + c;
#pragma unroll
            for (int e = 0; e < 4; ++e) { const unsigned a = uu[e], b = gc[e];
                acc[2 * e] += w[2 * e] * (__uint_as_float(a << 16) * __uint_as_float(b << 16));
                acc[2 * e + 1] += w[2 * e + 1] * (__uint_as_float(a & 0xffff0000u) * __uint_as_float(b & 0xffff0000u)); }
        }
        const u32x4v gb = *(const u32x4v*)(PROJ + (size_t)row * NAB + 6144 + c);
        u32x4v o;
#pragma unroll
        for (int e = 0; e < 4; ++e) o[e] = pk2(acc[2 * e] * __uint_as_float(gb[e] << 16), acc[2 * e + 1] * __uint_as_float(gb[e] & 0xffff0000u));
        *(u32x4v*)(Y + (size_t)row * DM + 1024 + c) = o;
    }
}
DEV void phase_scan_naive(const Params& p, unsigned char* shm) {
    float* Fb = (float*)shm;
    float* Kb = Fb + 4096; float* Qb = Kb + 4096;
    float* Vb = Qb + 4096;
    float* Op = Vb + 1024;
    const bf16_t* PROJ = (const bf16_t*)(p.ws + OFF_BIG);
    const bf16_t* CPROJ = PROJ + (size_t)MTOK * NAB;
    float* OFB = (float*)(p.ws + OFF_T1);
    const int tid = threadIdx.x, lane = tid & 63, wave = tid >> 6;
    const int v = tid & 31, kg = tid >> 5;
    const int tl = tid >> 4, kc = (tid & 15) * 8;
    for (int item = blockIdx.x; item < 256; item += gridDim.x) {
        const int vs = item & 3, dir = (item >> 2) & 1, h = (item >> 3) & 7, b = item >> 6;
        float lbv[8];
#pragma unroll
        for (int e = 0; e < 8; ++e) { const float* lp = p.lb_logits + dir * 3072 + h * 128 + kc + e; const float l0 = lp[0], l1 = lp[1024], l2 = lp[2048];
            const float mx = fmaxf(l0, fmaxf(l1, l2)); const float e0 = expf(l0 - mx), e1 = expf(l1 - mx), e2 = expf(l2 - mx); lbv[e] = e0 / (e0 + e1 + e2); }
        float S[8];
#pragma unroll
        for (int e = 0; e < 8; ++e) S[e] = 0.f;
        float* Oout = OFB + (size_t)dir * MTOK * AW;
        for (int batch = 0; batch < 72; ++batch) {
            const int i0 = batch * 32; const bool isctx = i0 < CTXL;
            {
                const int i = i0 + tl;
                const bf16_t* rp;
                if (isctx) { const int tk = dir ? (CTXL - 1 - i) : i; rp = CPROJ + (size_t)(b * CTXL + tk) * NAB; }
                else { const int jj = i - CTXL; const int tk = dir ? (SEQ - 1 - jj) : jj; rp = PROJ + (size_t)(b * SEQ + tk) * NAB; }
                const u32x4v zz = *(const u32x4v*)(rp + dir * 1024 + h * 128 + kc);
                u32x4v qq = {0u, 0u, 0u, 0u};
                if (!isctx) qq = *(const u32x4v*)(rp + 3072 + h * 128 + kc);
#pragma unroll
                for (int e = 0; e < 4; ++e) {
                    const float z0 = __uint_as_float(zz[e] << 16), z1 = __uint_as_float(zz[e] & 0xffff0000u);
                    const float f0 = lbv[2 * e] + (1.f - lbv[2 * e]) * sigm(z0), f1 = lbv[2 * e + 1] + (1.f - lbv[2 * e + 1]) * sigm(z1);
                    Fb[tl * 128 + kc + 2 * e] = f0; Fb[tl * 128 + kc + 2 * e + 1] = f1;
                    Kb[tl * 128 + kc + 2 * e] = 1.f - f0; Kb[tl * 128 + kc + 2 * e + 1] = 1.f - f1;
                    Qb[tl * 128 + kc + 2 * e] = __uint_as_float(qq[e] << 16); Qb[tl * 128 + kc + 2 * e + 1] = __uint_as_float(qq[e] & 0xffff0000u); }
                if (tid < 128) { const int t2 = tid >> 2, vc = (tid & 3) * 8; const int i2 = i0 + t2;
                    const bf16_t* rp2;
                    if (isctx) { const int tk = dir ? (CTXL - 1 - i2) : i2; rp2 = CPROJ + (size_t)(b * CTXL + tk) * NAB; }
                    else { const int jj = i2 - CTXL; const int tk = dir ? (SEQ - 1 - jj) : jj; rp2 = PROJ + (size_t)(b * SEQ + tk) * NAB; }
                    const u32x4v vv = *(const u32x4v*)(rp2 + 2048 + h * 128 + vs * 32 + vc);
#pragma unroll
                    for (int e = 0; e < 4; ++e) { Vb[t2 * 32 + vc + 2 * e] = __uint_as_float(vv[e] << 16); Vb[t2 * 32 + vc + 2 * e + 1] = __uint_as_float(vv[e] & 0xffff0000u); } }
            }
            __syncthreads();
            for (int t = 0; t < 32; ++t) {
                const pg8::f32x4 f0 = *(const pg8::f32x4*)(Fb + t * 128 + kg * 8), f1 = *(const pg8::f32x4*)(Fb + t * 128 + kg * 8 + 4);
                const pg8::f32x4 k0 = *(const pg8::f32x4*)(Kb + t * 128 + kg * 8), k1 = *(const pg8::f32x4*)(Kb + t * 128 + kg * 8 + 4);
                const pg8::f32x4 q0 = *(const pg8::f32x4*)(Qb + t * 128 + kg * 8), q1 = *(const pg8::f32x4*)(Qb + t * 128 + kg * 8 + 4);
                const float vv = Vb[t * 32 + v];
                float o = 0.f;
#pragma unroll
                for (int e = 0; e < 4; ++e) { S[e] = f0[e] * S[e] + k0[e] * vv; o += S[e] * q0[e]; S[4 + e] = f1[e] * S[4 + e] + k1[e] * vv; o += S[4 + e] * q1[e]; }
                o += __shfl_xor(o, 32);
                if (lane < 32) Op[(t * 8 + wave) * 32 + v] = o;
            }
            __syncthreads();
            if (!isctx) {
#pragma unroll
                for (int r = 0; r < 2; ++r) { const int idx = tid + 512 * r, t = idx >> 5, vv = idx & 31;
                    float s = 0.f;
#pragma unroll
                    for (int w = 0; w < 8; ++w) s += Op[(t * 8 + w) * 32 + vv];
                    const int jj = i0 + t - CTXL; const int tk = dir ? (SEQ - 1 - jj) : jj;
                    Oout[(size_t)(b * SEQ + tk) * AW + h * 128 + vs * 32 + vv] = s; }
            }
        }
        __syncthreads();
    }
}
DEV void phase_readout(const Params& p) {
    const bf16_t* PROJ = (const bf16_t*)(p.ws + OFF_BIG);
    const float* OF = (const float*)(p.ws + OFF_T1); const float* OB = OF + (size_t)MTOK * AW;
    bf16_t* Y = (bf16_t*)(p.ws + OFF_Y);
    const int wave = threadIdx.x >> 6, lane = threadIdx.x & 63;
    const int gw = blockIdx.x * 8 + wave, NGW = gridDim.x * 8;
    for (int row = gw; row < MTOK; row += NGW) {
        const int c0 = lane * 16;
        float o[16]; float ss = 0.f;
#pragma unroll
        for (int j = 0; j < 4; ++j) { const pg8::f32x4 a = *(const pg8::f32x4*)(OF + (size_t)row * AW + c0 + 4 * j), bq = *(const pg8::f32x4*)(OB + (size_t)row * AW + c0 + 4 * j);
#pragma unroll
            for (int e = 0; e < 4; ++e) { o[4 * j + e] = a[e] + bq[e]; ss += o[4 * j + e] * o[4 * j + e]; } }
        ss += __shfl_xor(ss, 1); ss += __shfl_xor(ss, 2); ss += __shfl_xor(ss, 4);
        const float rstd = rsqrtf(ss * (1.f / DH) + EPS);
#pragma unroll
        for (int hh = 0; hh < 2; ++hh) {
            const u32x4v gg = *(const u32x4v*)(PROJ + (size_t)row * NAB + 4096 + c0 + 8 * hh);
            u32x4v w;
#pragma unroll
            for (int e = 0; e < 4; ++e) { const int ci = 8 * hh + 2 * e;
                const float g0 = __uint_as_float(gg[e] << 16), g1 = __uint_as_float(gg[e] & 0xffff0000u);
                w[e] = pk2(o[ci] * rstd * p.ab_gnorm_g[c0 + ci] * siluf(g0), o[ci + 1] * rstd * p.ab_gnorm_g[c0 + ci + 1] * siluf(g1)); }
            *(u32x4v*)(Y + (size_t)row * DM + c0 + 8 * hh) = w; }
    }
}
DEV void phase_hyprep(const Params& p, unsigned char* shm) {
    const bf16_t* P = (const bf16_t*)(p.ws + OFF_BIG);
    bf16_t* T2 = (bf16_t*)(p.ws + OFF_T2);
    const int wave = threadIdx.x >> 6, lane = threadIdx.x & 63;
    float* scr = (float*)shm + wave * (64 * 65);
    const int gw = blockIdx.x * 8 + wave, NGW = gridDim.x * 8;
    for (int it = gw; it < 128 * 96; it += NGW) {
        const int ct = it % 96, tt = it / 96, tok0 = tt * 64, c0 = ct * 64;
#pragma unroll 8
        for (int i = 0; i < 64; ++i) scr[i * 65 + lane] = bf2f(P[(size_t)(tok0 + i) * NHY + c0 + lane]);
        lds_fence();
        const int which = c0 >> 11;
        bf16_t* dst = T2 + (size_t)which * (2048 * 8192) + (size_t)(c0 - which * 2048) * 8192 + tok0 + lane;
        for (int cc = 0; cc < 64; ++cc) {
            const float w0 = p.hy_short_w[c0 + cc], w1 = p.hy_short_w[NHY + c0 + cc], w2 = p.hy_short_w[2 * NHY + c0 + cc];
            const float cen = scr[lane * 65 + cc];
            const float lf = lane > 0 ? scr[(lane - 1) * 65 + cc] : 0.f;
            const float rt = lane < 63 ? scr[(lane + 1) * 65 + cc] : 0.f;
            dst[(size_t)cc * 8192] = f2bf(w0 * lf + w1 * cen + w2 * rt);
        }
        lds_fence();
    }
    __syncthreads();
}
DEV void phase_longconv_naive(const Params& p, unsigned char* shm) {
    float* Tn = (float*)shm; float* Za = Tn + 4096; float* Zb = Za + 8192; float* red = Zb + 8192;
    bf16_t* T2 = (bf16_t*)(p.ws + OFF_T2);
    const float* TAPS = (const float*)(p.ws + OFF_T1);
    const int tid = threadIdx.x, lane = tid & 63, wave = tid >> 6;
    for (int d = blockIdx.x; d < DM; d += gridDim.x) {
        bf16_t* ZT = T2 + (size_t)2 * (2048 * 8192) + (size_t)d * 8192;
        const bf16_t* X1T = T2 + (size_t)d * 8192; const bf16_t* X2T = T2 + (size_t)(2048 * 8192) + (size_t)d * 8192;
        for (int idx = tid; idx < 8192; idx += 512) Za[idx] = bf2f(ZT[idx]);
        for (int o = 0; o < 2; ++o) {
            const float* T = TAPS + ((size_t)(o * 2048 + d)) * 4096;
            float tv[8]; float s = 0.f;
#pragma unroll
            for (int r = 0; r < 8; ++r) { tv[r] = T[tid + 512 * r]; s += fabsf(tv[r]); }
            s = wave_sum(s); if (lane == 0) red[wave] = s;
            __syncthreads();
            float tot = 0.f;
#pragma unroll
            for (int w = 0; w < 8; ++w) tot += red[w];
            const float inv = 1.f / tot;
#pragma unroll
            for (int r = 0; r < 8; ++r) Tn[tid + 512 * r] = tv[r] * inv;
            __syncthreads();
            const float* src = o == 0 ? Za : Zb; float* dst = o == 0 ? Zb : Za;
            float acc[4][4];
#pragma unroll
            for (int b = 0; b < 4; ++b)
#pragma unroll
                for (int j = 0; j < 4; ++j) acc[b][j] = 0.f;
            for (int si = 0; si < 512; ++si) {
                const int m0 = 4 * (tid - si) + 2048;
                const pg8::f32x4 lo = *(const pg8::f32x4*)(Tn + m0 - 4), hi = *(const pg8::f32x4*)(Tn + m0);
                float tw[8]; tw[0] = lo[0]; tw[1] = lo[1]; tw[2] = lo[2]; tw[3] = lo[3]; tw[4] = hi[0]; tw[5] = hi[1]; tw[6] = hi[2]; tw[7] = hi[3];
#pragma unroll
                for (int b = 0; b < 4; ++b) { const pg8::f32x4 zz = *(const pg8::f32x4*)(src + b * 2048 + 4 * si);
#pragma unroll
                    for (int j = 0; j < 4; ++j)
#pragma unroll
                        for (int i = 0; i < 4; ++i) acc[b][j] += tw[4 + j - i] * zz[i]; }
            }
            const float skip = p.skip[o * 2048 + d];
            const bf16_t* gate = o == 0 ? X1T : X2T;
            float res[4][4];
#pragma unroll
            for (int b = 0; b < 4; ++b)
#pragma unroll
                for (int j = 0; j < 4; ++j) { const int t = 4 * tid + j; res[b][j] = bf2f(gate[b * 2048 + t]) * (acc[b][j] + src[b * 2048 + t] * skip); }
#pragma unroll
            for (int b = 0; b < 4; ++b)
#pragma unroll
                for (int j = 0; j < 4; ++j) dst[b * 2048 + 4 * tid + j] = res[b][j];
            __syncthreads();
        }
        for (int idx = tid; idx < 8192; idx += 512) ZT[idx] = f2bf(Za[idx]);
        __syncthreads();
    }
}
typedef float f32x16 __attribute__((ext_vector_type(16)));
DEV void phase_longconv_mfma(const Params& p, unsigned char* shm) {
    unsigned char* TC = shm;
    unsigned char* ZA = shm + 65792;
    unsigned char* ZB = ZA + 25600;
    float* red = (float*)(ZB + 25600);
    bf16_t* T2 = (bf16_t*)(p.ws + OFF_T2);
    const float* TAPS = (const float*)(p.ws + OFF_T1);
    const int tid = threadIdx.x, lane = tid & 63, wave = __builtin_amdgcn_readfirstlane(tid >> 6);
    for (int i = tid; i < 2 * 64 * 5; i += 512) { const int bufi = i / 320, r = i % 320, hc = r / 5, part = r % 5; const int col = hc < 32 ? hc : 256 + hc;
        *(u32x4v*)((bufi ? ZB : ZA) + col * 80 + part * 16) = (u32x4v){0u, 0u, 0u, 0u}; }
    const int nt = wave, n = lane & 31, g = lane >> 5, il = n & 7, ih = n >> 3;
    const int dlo = (8 * nt - 63) > -63 ? (8 * nt - 63) : -63, dhi = (8 * nt + 7) < 63 ? (8 * nt + 7) : 63;
    for (int d = blockIdx.x; d < DM; d += gridDim.x) {
        bf16_t* ZT = T2 + (size_t)2 * (2048 * 8192) + (size_t)d * 8192;
        const bf16_t* X1T = T2 + (size_t)d * 8192; const bf16_t* X2T = T2 + (size_t)(2048 * 8192) + (size_t)d * 8192;
        __syncthreads();
#pragma unroll
        for (int r = 0; r < 2; ++r) { const int e0 = (tid + 512 * r) * 8, b = e0 >> 11, t = e0 & 2047, s1 = t >> 5, s2 = t & 31;
            *(u32x4v*)(ZA + ((4 * s1 + b + 32) * 40 + s2) * 2) = *(const u32x4v*)(ZT + e0); }
        for (int o = 0; o < 2; ++o) {
            {
                const float* T = TAPS + ((size_t)(o * 2048 + d)) * 4096;
                const int mb = 4088 - 8 * tid;
                float v[16];
#pragma unroll
                for (int i = 0; i < 4; ++i) { pg8::f32x4 f = {0.f, 0.f, 0.f, 0.f}; if (mb + 4 * i < 4096) f = *(const pg8::f32x4*)(T + mb + 4 * i);
                    v[4 * i] = f[0]; v[4 * i + 1] = f[1]; v[4 * i + 2] = f[2]; v[4 * i + 3] = f[3]; }
                float s = 0.f;
#pragma unroll
                for (int i = 8; i < 16; ++i) s += fabsf(v[i]);
                if (tid == 511) {
#pragma unroll
                    for (int i = 1; i < 8; ++i) s += fabsf(v[i]); }
                s = wave_sum(s); if (lane == 0) red[o * 8 + wave] = s;
#pragma unroll
                for (int c = 0; c < 8; ++c) { u32x4v w; w.x = pk2(v[8 + c], v[7 + c]); w.y = pk2(v[6 + c], v[5 + c]); w.z = pk2(v[4 + c], v[3 + c]); w.w = pk2(v[2 + c], v[1 + c]);
                    *(u32x4v*)(TC + c * 8224 + tid * 16) = w; }
            }
            __syncthreads();
            float tot = 0.f;
#pragma unroll
            for (int w = 0; w < 8; ++w) tot += red[o * 8 + w];
            const float inv = 1.f / tot;
            unsigned char* src = o == 0 ? ZA : ZB;
            const unsigned char* ap = TC + il * 8224 + 2 * (2048 + 8 * (g - ih)) - 64 * dlo;
            const unsigned char* bp = src + ((32 * nt + n + 32) * 40 + 8 * g) * 2 - 320 * dlo;
            f32x16 acc0, acc1;
#pragma unroll
            for (int i = 0; i < 16; ++i) { acc0[i] = 0.f; acc1[i] = 0.f; }
            pg8::bf16x8 a0 = *(const pg8::bf16x8*)ap, a1 = *(const pg8::bf16x8*)(ap + 32), b0 = *(const pg8::bf16x8*)bp, b1 = *(const pg8::bf16x8*)(bp + 32);
            for (int dl = dlo; dl < dhi; ++dl) {
                ap -= 64; bp -= 320;
                const pg8::bf16x8 na0 = *(const pg8::bf16x8*)ap, na1 = *(const pg8::bf16x8*)(ap + 32), nb0 = *(const pg8::bf16x8*)bp, nb1 = *(const pg8::bf16x8*)(bp + 32);
                acc0 = __builtin_amdgcn_mfma_f32_32x32x16_bf16(a0, b0, acc0, 0, 0, 0);
                acc1 = __builtin_amdgcn_mfma_f32_32x32x16_bf16(a1, b1, acc1, 0, 0, 0);
                a0 = na0; a1 = na1; b0 = nb0; b1 = nb1;
            }
            acc0 = __builtin_amdgcn_mfma_f32_32x32x16_bf16(a0, b0, acc0, 0, 0, 0);
            acc1 = __builtin_amdgcn_mfma_f32_32x32x16_bf16(a1, b1, acc1, 0, 0, 0);
            const float skip = p.skip[o * 2048 + d];
            const bf16_t* gate = o == 0 ? X1T : X2T;
            const int j = n >> 2, b = n & 3, t1 = 8 * nt + j;
#pragma unroll
            for (int rg = 0; rg < 4; ++rg) {
                const int t2 = 8 * rg + 4 * g, gidx = b * 2048 + 32 * t1 + t2, lo = ((4 * t1 + b + 32) * 40 + t2) * 2;
                const unsigned long long gg = *(const unsigned long long*)(gate + gidx), zz = *(const unsigned long long*)(src + lo);
                float val[4];
#pragma unroll
                for (int e = 0; e < 4; ++e) { const float gv = __uint_as_float((unsigned)((gg >> (16 * e)) & 0xffffull) << 16), zv = __uint_as_float((unsigned)((zz >> (16 * e)) & 0xffffull) << 16);
                    val[e] = gv * (inv * (acc0[4 * rg + e] + acc1[4 * rg + e]) + zv * skip); }
                const unsigned long long ov = (unsigned long long)pk2(val[0], val[1]) | ((unsigned long long)pk2(val[2], val[3]) << 32);
                if (o == 0) *(unsigned long long*)(ZB + lo) = ov; else *(unsigned long long*)(ZT + gidx) = ov;
            }
            __syncthreads();
        }
    }
}
DEV void phase_transback(const Params& p, unsigned char* shm) {
    const bf16_t* ZT = (const bf16_t*)(p.ws + OFF_T2) + (size_t)2 * (2048 * 8192);
    bf16_t* Y = (bf16_t*)(p.ws + OFF_Y);
    const int wave = threadIdx.x >> 6, lane = threadIdx.x & 63;
    unsigned short* scr = (unsigned short*)shm + wave * (64 * 66);
    const int gw = blockIdx.x * 8 + wave, NGW = gridDim.x * 8;
    for (int it = gw; it < 32 * 128; it += NGW) {
        const int ct = it & 31, tt = it >> 5, c0 = ct * 64, tok0 = tt * 64;
#pragma unroll 8
        for (int i = 0; i < 64; ++i) scr[i * 66 + lane] = ZT[(size_t)(c0 + i) * 8192 + tok0 + lane];
        lds_fence();
#pragma unroll 8
        for (int t = 0; t < 64; ++t) Y[(size_t)(tok0 + t) * DM + c0 + lane] = scr[lane * 66 + t];
        lds_fence();
    }
    __syncthreads();
}

enum { P_PREP = 0, P_NORM0, P_GEMM_IN, P_SCAN, P_READOUT, P_GEMM_OUT0, P_NORM0B, P_GEMM_UP0, P_GEMM_DN0, P_NORM1, P_GEMM_HYIN, P_HYPREP, P_LCONV, P_TRANSB,
       P_GEMM_OUT1, P_NORM1B, P_GEMM_UP1, P_GEMM_DN1, P_FINAL, NPHASE };

template <int KK, int NN, class Epi>
DEV void run_gemm(unsigned char* shm, const bf16_t* A, const bf16_t* Bt, const Epi& E, int exn, int expm0, int exnN) {
    pg8::Gemm g; g.A = A; g.Bt = Bt; g.M = MTOK; g.N = NN; g.K = KK;
    OrderX S; S.init(MTOK, NN, gridDim.x, blockIdx.x, exn, expm0, exnN);
    pg8::gemm_phase<Epi, OrderX, true, true>((PG8_LAS unsigned char*)shm, g, S, E);
}

__global__ __launch_bounds__(512, 2) void mega(Params p) {
    extern __shared__ __attribute__((aligned(16))) unsigned char shm[];
    cg::grid_group grid = cg::this_grid();
    const int lo = p.ph_lo, hi = p.ph_hi;
#ifndef KEEPMASK
#define KEEPMASK 0xFFFFFFFFu
#endif
#define IN(k) ((((KEEPMASK) >> (k)) & 1u) && lo <= (k) && (k) < hi)
#define SEAM(k) do { if (IN(k) && IN((k) + 1)) grid.sync(); } while (0)
#define WS(T, off) ((T*)(p.ws + (off)))
    if (IN(P_PREP)) {
#ifndef NO_ADA
        phase_ada(p, shm); __syncthreads();
#endif
#ifndef NO_HDN
        phase_hdn(p, shm); __syncthreads();
#endif
#ifndef NO_CONV
        phase_convert(p, shm);
#endif
    }
    SEAM(P_PREP);
    if (IN(P_NORM0)) {
        norm_rows(p.x, MTOK, SEQ, p.norm_g, WS(float, OFF_MOD), 12288, 0, DM, WS(bf16_t, OFF_H));
        norm_rows(p.ctx, MCTX, MCTX, p.norm_g, WS(float, OFF_MOD) + (size_t)4 * 12288, 0, 0, DM, WS(bf16_t, OFF_H) + (size_t)MTOK * DM);
    }
    SEAM(P_NORM0);
    if (IN(P_GEMM_IN)) { EpiBf16<0> E; E.O = WS(bf16_t, OFF_BIG); E.ldc = NAB; run_gemm<2048, NAB>(shm, WS(bf16_t, OFF_H), WS(bf16_t, OFF_WIN), E, 48, 32, 12); }
    SEAM(P_GEMM_IN);
    if (IN(P_SCAN)) { phase_convbranch(p); phase_scan_naive(p, shm); }
    SEAM(P_SCAN);
    if (IN(P_READOUT)) phase_readout(p);
    SEAM(P_READOUT);
    if (IN(P_GEMM_OUT0)) { EpiResid E; E.gstride = 12288; E.R = p.x; E.C = WS(float, OFF_X1); E.gate = WS(float, OFF_MOD) + 2 * DM;
        run_gemm<2048, DM>(shm, WS(bf16_t, OFF_Y), WS(bf16_t, OFF_WOUT), E, 0, 0, 1); }
    SEAM(P_GEMM_OUT0);
    if (IN(P_NORM0B)) norm_rows(WS(float, OFF_X1), MTOK, SEQ, p.norm_g + DM, WS(float, OFF_MOD), 12288, 3 * DM, 4 * DM, WS(bf16_t, OFF_H));
    SEAM(P_NORM0B);
    if (IN(P_GEMM_UP0)) { EpiBf16<1> E; E.O = WS(bf16_t, OFF_BIG); E.ldc = FF; run_gemm<2048, FF>(shm, WS(bf16_t, OFF_H), WS(bf16_t, OFF_W1_0), E, 0, 0, 1); }
    SEAM(P_GEMM_UP0);
    if (IN(P_GEMM_DN0)) { EpiResid E; E.gstride = 12288; E.R = WS(float, OFF_X1); E.C = WS(float, OFF_X2); E.gate = WS(float, OFF_MOD) + 5 * DM;
        run_gemm<8192, DM>(shm, WS(bf16_t, OFF_BIG), WS(bf16_t, OFF_W2_0), E, 0, 0, 1); }
    SEAM(P_GEMM_DN0);
    if (IN(P_NORM1)) { norm_rows(WS(float, OFF_X2), MTOK, SEQ, p.norm_g + 2 * DM, WS(float, OFF_MOD) + (size_t)5 * 12288, 12288, 0, DM, WS(bf16_t, OFF_H)); phase_taps(p); }
    SEAM(P_NORM1);
    if (IN(P_GEMM_HYIN)) { EpiBf16<0> E; E.O = WS(bf16_t, OFF_BIG); E.ldc = NHY; run_gemm<2048, NHY>(shm, WS(bf16_t, OFF_H), WS(bf16_t, OFF_HYIN), E, 0, 0, 1); }
    SEAM(P_GEMM_HYIN);
    if (IN(P_HYPREP)) phase_hyprep(p, shm);
    SEAM(P_HYPREP);
    if (IN(P_LCONV)) phase_longconv_mfma(p, shm);
    SEAM(P_LCONV);
    if (IN(P_TRANSB)) phase_transback(p, shm);
    SEAM(P_TRANSB);
    if (IN(P_GEMM_OUT1)) { EpiResid E; E.gstride = 12288; E.R = WS(float, OFF_X2); E.C = WS(float, OFF_X1); E.gate = WS(float, OFF_MOD) + (size_t)5 * 12288 + 2 * DM;
        run_gemm<2048, DM>(shm, WS(bf16_t, OFF_Y), WS(bf16_t, OFF_HYOUT), E, 0, 0, 1); }
    SEAM(P_GEMM_OUT1);
    if (IN(P_NORM1B)) norm_rows(WS(float, OFF_X1), MTOK, SEQ, p.norm_g + 3 * DM, WS(float, OFF_MOD) + (size_t)5 * 12288, 12288, 3 * DM, 4 * DM, WS(bf16_t, OFF_H));
    SEAM(P_NORM1B);
    if (IN(P_GEMM_UP1)) { EpiBf16<1> E; E.O = WS(bf16_t, OFF_BIG); E.ldc = FF; run_gemm<2048, FF>(shm, WS(bf16_t, OFF_H), WS(bf16_t, OFF_W1_1), E, 0, 0, 1); }
    SEAM(P_GEMM_UP1);
    if (IN(P_GEMM_DN1)) { EpiResid E; E.gstride = 12288; E.R = WS(float, OFF_X1); E.C = WS(float, OFF_X2); E.gate = WS(float, OFF_MOD) + (size_t)5 * 12288 + 5 * DM;
        run_gemm<8192, DM>(shm, WS(bf16_t, OFF_BIG), WS(bf16_t, OFF_W2_1), E, 0, 0, 1); }
    SEAM(P_GEMM_DN1);
    if (IN(P_FINAL)) final_norm_rows(WS(float, OFF_X2), p.final_g, p.out);
#undef IN
#undef SEAM
#undef WS
}

extern "C" void kernel_launch(void* const* d_in, const int* in_sizes, int n_in, void* d_out, int out_size, void* d_ws, size_t ws_size, hipStream_t stream) {
    static int grid = 0;
    if (grid == 0) {
        if (n_in != 27 || ws_size < WS_END) { fprintf(stderr, "kernel_launch: unexpected n_in %d or workspace %zu < %zu\n", n_in, ws_size, (size_t)WS_END); grid = -1; return; }
        int dev = 0, cus = 0, per_cu = 0;
        hipGetDevice(&dev); hipDeviceGetAttribute(&cus, hipDeviceAttributeMultiprocessorCount, dev);
        if (hipFuncSetAttribute((const void*)mega, hipFuncAttributeMaxDynamicSharedMemorySize, LDS_BYTES) != hipSuccess) { fprintf(stderr, "kernel_launch: hipFuncSetAttribute failed\n"); grid = -1; return; }
        if (hipOccupancyMaxActiveBlocksPerMultiprocessor(&per_cu, (const void*)mega, 512, LDS_BYTES) != hipSuccess || per_cu < 1) { fprintf(stderr, "kernel_launch: occupancy query gave %d\n", per_cu); per_cu = 1; }
        (void)hipGetLastError();
        grid = cus * per_cu;
    }
    if (grid < 0) return;
    Params p{};
    const float** f = (const float**)&p;
    for (int i = 0; i < 27; ++i) f[i] = (const float*)d_in[i];
    p.out = (float*)d_out; p.ws = (unsigned char*)d_ws; p.ph_lo = 0; p.ph_hi = NPHASE;
    void* args[] = {&p};
    hipError_t e = hipLaunchCooperativeKernel((const void*)mega, dim3(grid), dim3(512), args, LDS_BYTES, stream);
    if (e != hipSuccess) fprintf(stderr, "cooperative launch failed: %s (grid %d)\n", hipGetErrorString(e), grid);
}
```

```cpp
#include <hip/hip_runtime.h>
#include <hip/hip_cooperative_groups.h>
#include <cstdio>
#include <cstdint>
namespace cg = cooperative_groups;
namespace pg8 {
#define PG8_LAS __attribute__((address_space(3)))
typedef unsigned short bf16_t;
typedef short bf16x8 __attribute__((ext_vector_type(8)));
typedef float f32x4 __attribute__((ext_vector_type(4)));
typedef unsigned u32x4 __attribute__((ext_vector_type(4)));
constexpr int BM = 256, BK = 64, HALF = 128, HTB = HALF * BK * 2  , STAGE_BYTES = 8 * HTB, NXCD = 8, WGM = 8;

__host__ __device__ __forceinline__ int lds_byte(int r, int c) { const int st = (r >> 4) * 2 + (c >> 5), rr = r & 15, cc = c & 31, ob = rr * 64 + cc * 2; return st * 1024 + (ob ^ (((ob >> 9) & 1) << 5)); }
__host__ __device__ __forceinline__ void stage_rc(int b, int& R, int& C) { const int st = b / 1024, sb = b % 1024, swz = sb ^ (((sb >> 9) & 1) << 5); R = (st >> 1) * 16 + swz / 64; C = (st & 1) * 32 + (swz % 64) / 2; }
__host__ __device__ __forceinline__ int perm32(int rho) { const int n = rho >> 4, i = rho & 15; return 8 * (i >> 2) + 4 * n + (i & 3); }

struct Unit { int pm, pn; };
struct Gemm { const bf16_t* A; const bf16_t* Bt; int M, N, K; };

struct StaticOrder {
    int nM, nN, nwg, G, c;
    __host__ __device__ void init(int M, int N, int G_, int c_) { nM = M / BM; nN = N / BM; nwg = nM * nN; G = G_; c = c_; }
    __host__ __device__ bool next(int i, Unit& u) const {
        const long L = (long)i * G + c; if (L >= nwg) return false;
        int wgid = (int)L; { const int q = nwg / NXCD, r = nwg % NXCD, xcd = wgid % NXCD, off = wgid / NXCD; wgid = (xcd < r ? xcd * (q + 1) : r * (q + 1) + (xcd - r) * q) + off; }
        const int nig = WGM * nN, gid = wgid / nig, fm = gid * WGM, gsz = (nM - fm) < WGM ? (nM - fm) : WGM;
        u.pm = fm + ((wgid % nig) % gsz); u.pn = (wgid % nig) / gsz; return true;
    }
    __device__ __forceinline__ void a_ready(const Unit&) const {}
    __device__ __forceinline__ void done(const Unit&) const {}
};
__device__ __forceinline__ unsigned cvt_pk_bf16(float lo, float hi) { unsigned r; asm volatile("v_cvt_pk_bf16_f32 %0, %1, %2" : "=v"(r) : "v"(lo), "v"(hi)); return r; }
template <class Epi, class Sched, bool ALIGN_EPI = false, bool SP2 = false>
__device__ __forceinline__ void gemm_phase(PG8_LAS unsigned char* lds, const Gemm g, const Sched& S, const Epi& E) {
    const int tid = threadIdx.x, wid = __builtin_amdgcn_readfirstlane(tid >> 6), lane = tid & 63, wr = wid >> 2, wc = wid & 3, fr = lane & 15, fq = lane >> 4;
    const int K = g.K, nt = K / BK;
    unsigned voffA[2], voffB[2];
#pragma unroll
    for (int i = 0; i < 2; ++i) { int R, C; stage_rc(tid * 16 + i * 8192, R, C); const int Rb = Epi::PERM ? ((R & ~31) + perm32(R & 31)) : R;
        voffA[i] = (unsigned)(R * K + C) * 2u; voffB[i] = (unsigned)(Rb * K + C) * 2u; }
    const size_t kstep = (size_t)(BK * 2);
    const size_t hstep = (size_t)HALF * K * 2;
    const size_t tstep = 2 * hstep;
    const unsigned ldsw = (unsigned)wid * 1024u;
    const int aoff = lds_byte(wr * 64 + fr, fq * 8), boff = lds_byte(wc * 32 + fr, fq * 8);
#define PG8_SA(b, h) (((b) * 2 + (h)) * HTB)
#define PG8_SB(b, h) ((4 + (b) * 2 + (h)) * HTB)
#define PG8_STAGE(bufoff, gbase, voff) do { _Pragma("unroll") for (int _i = 0; _i < 2; ++_i) \
        __builtin_amdgcn_global_load_lds((const unsigned*)((const char*)(gbase) + (voff)[_i]), (PG8_LAS unsigned*)(lds + (bufoff) + ldsw + _i * 8192), 16, 0, 0); } while (0)
#define PG8_LDA(dst, b, h) do { _Pragma("unroll") for (int m = 0; m < 4; ++m) _Pragma("unroll") for (int k = 0; k < 2; ++k) dst[m][k] = *(const PG8_LAS bf16x8*)(lds + PG8_SA(b, h) + aoff + m * 2048 + k * 1024); } while (0)
#define PG8_LDB(dst, b, h) do { _Pragma("unroll") for (int n = 0; n < 2; ++n) _Pragma("unroll") for (int k = 0; k < 2; ++k) dst[n][k] = *(const PG8_LAS bf16x8*)(lds + PG8_SB(b, h) + boff + n * 2048 + k * 1024); } while (0)
#define PG8_MMA(ai, bj, At, Bt) do { __builtin_amdgcn_s_setprio(1); _Pragma("unroll") for (int m = 0; m < 4; ++m) _Pragma("unroll") for (int n = 0; n < 2; ++n) _Pragma("unroll") for (int k = 0; k < 2; ++k) \
        acc[ai][bj][m][n] = __builtin_amdgcn_mfma_f32_16x16x32_bf16(Bt[n][k], At[m][k], acc[ai][bj][m][n], 0, 0, 0); __builtin_amdgcn_s_setprio(0); } while (0)
#define PG8_WAIT_V(n) asm volatile("s_waitcnt vmcnt(" #n ")" ::: "memory")
#define PG8_WAIT_L(n) asm volatile("s_waitcnt lgkmcnt(" #n ")" ::: "memory")
#define PG8_BAR __builtin_amdgcn_s_barrier()
#define PG8_SCHED __builtin_amdgcn_sched_barrier(0)
    Unit cur, nxt; int ui = 0;
    if (!S.next(0, cur)) return;
    f32x4 acc[2][2][4][2];
#pragma unroll
    for (int a = 0; a < 2; ++a)
#pragma unroll
        for (int b = 0; b < 2; ++b)
#pragma unroll
            for (int m = 0; m < 4; ++m)
#pragma unroll
                for (int n = 0; n < 2; ++n) acc[a][b][m][n] = (f32x4){0.f, 0.f, 0.f, 0.f};
    bf16x8 At[4][2], B0[2][2], B1[2][2];
    const char* cA = (const char*)g.A + (size_t)cur.pm * tstep; const char* cB = (const char*)g.Bt + (size_t)cur.pn * tstep;
    S.a_ready(cur);
    if constexpr (SP2) {
        PG8_STAGE(PG8_SB(0, 0), cB, voffB); PG8_STAGE(PG8_SB(0, 1), cB + hstep, voffB); PG8_STAGE(PG8_SA(0, 0), cA, voffA); PG8_STAGE(PG8_SA(0, 1), cA + hstep, voffA);
        if (wr == 1) PG8_BAR;
        PG8_WAIT_V(2); PG8_BAR;
        PG8_STAGE(PG8_SB(1, 0), cB + kstep, voffB); PG8_STAGE(PG8_SA(1, 0), cA + kstep, voffA); PG8_STAGE(PG8_SB(1, 1), cB + hstep + kstep, voffB);
        PG8_WAIT_V(6); PG8_BAR;
    } else {
        PG8_STAGE(PG8_SB(0, 0), cB, voffB); PG8_STAGE(PG8_SA(0, 0), cA, voffA); PG8_STAGE(PG8_SB(0, 1), cB + hstep, voffB); PG8_STAGE(PG8_SA(0, 1), cA + hstep, voffA);
        if (wr == 1) PG8_BAR;
        PG8_WAIT_V(4); PG8_BAR;
        PG8_STAGE(PG8_SB(1, 0), cB + kstep, voffB); PG8_STAGE(PG8_SA(1, 0), cA + kstep, voffA); PG8_STAGE(PG8_SB(1, 1), cB + hstep + kstep, voffB);
        PG8_WAIT_V(6); PG8_BAR;
    }
    for (;;) {
        const bool has_next = S.next(ui + 1, nxt);
        const char* nA = has_next ? (const char*)g.A + (size_t)nxt.pm * tstep : cA; const char* nB = has_next ? (const char*)g.Bt + (size_t)nxt.pn * tstep : cB;
        for (int t = 0; t < nt; t += 2) {
            const bool last = (t == nt - 2);
            const char* a1 = cA + (size_t)(t + 1) * kstep;
            const char* a2 = last ? nA : cA + (size_t)(t + 2) * kstep; const char* b2 = last ? nB : cB + (size_t)(t + 2) * kstep;
            const char* a3 = a2 + kstep; const char* b3 = b2 + kstep;
            if (last && has_next) S.a_ready(nxt);
            if constexpr (SP2) {
            PG8_LDB(B0, 0, 0); PG8_LDB(B1, 0, 1); PG8_SCHED; PG8_LDA(At, 0, 0); PG8_STAGE(PG8_SA(1, 1), a1 + hstep, voffA);
            PG8_WAIT_V(8); PG8_WAIT_L(0); PG8_BAR; PG8_MMA(0, 0, At, B0); PG8_MMA(0, 1, At, B1); PG8_BAR; PG8_SCHED;
            PG8_LDA(At, 0, 1); PG8_STAGE(PG8_SB(0, 0), b2, voffB); PG8_STAGE(PG8_SB(0, 1), b2 + hstep, voffB); PG8_STAGE(PG8_SA(0, 0), a2, voffA);
            PG8_WAIT_V(8); PG8_WAIT_L(0); PG8_BAR; PG8_MMA(1, 0, At, B0); PG8_MMA(1, 1, At, B1); PG8_BAR; PG8_SCHED;
            PG8_LDB(B0, 1, 0); PG8_LDB(B1, 1, 1); PG8_SCHED; PG8_LDA(At, 1, 0); PG8_STAGE(PG8_SA(0, 1), a2 + hstep, voffA);
            PG8_WAIT_V(8); PG8_WAIT_L(0); PG8_BAR; PG8_MMA(0, 0, At, B0); PG8_MMA(0, 1, At, B1); PG8_BAR; PG8_SCHED;
            PG8_LDA(At, 1, 1); PG8_STAGE(PG8_SB(1, 0), b3, voffB); PG8_STAGE(PG8_SB(1, 1), b3 + hstep, voffB); PG8_STAGE(PG8_SA(1, 0), a3, voffA);
            PG8_WAIT_V(8); PG8_WAIT_L(0); PG8_BAR; PG8_MMA(1, 0, At, B0); PG8_MMA(1, 1, At, B1); PG8_BAR; PG8_SCHED;
            } else {
            PG8_LDB(B0, 0, 0); PG8_SCHED; PG8_LDA(At, 0, 0); PG8_STAGE(PG8_SA(1, 1), a1 + hstep, voffA);
            PG8_WAIT_L(8); PG8_BAR; PG8_WAIT_L(0); PG8_MMA(0, 0, At, B0); PG8_BAR; PG8_SCHED;
            PG8_LDB(B1, 0, 1); PG8_STAGE(PG8_SB(0, 0), b2, voffB);
            PG8_BAR; PG8_WAIT_L(0); PG8_MMA(0, 1, At, B1); PG8_BAR;
            PG8_LDA(At, 0, 1); PG8_STAGE(PG8_SA(0, 0), a2, voffA);
            PG8_BAR; PG8_WAIT_L(0); PG8_MMA(1, 0, At, B0); PG8_BAR; PG8_SCHED;
            PG8_STAGE(PG8_SB(0, 1), b2 + hstep, voffB);
            PG8_WAIT_V(6); PG8_BAR; PG8_MMA(1, 1, At, B1); PG8_BAR;
            PG8_LDB(B0, 1, 0); PG8_SCHED; PG8_LDA(At, 1, 0); PG8_STAGE(PG8_SA(0, 1), a2 + hstep, voffA);
            PG8_WAIT_L(8); PG8_BAR; PG8_WAIT_L(0); PG8_MMA(0, 0, At, B0); PG8_BAR; PG8_SCHED;
            PG8_LDB(B1, 1, 1); PG8_STAGE(PG8_SB(1, 0), b3, voffB);
            PG8_BAR; PG8_WAIT_L(0); PG8_MMA(0, 1, At, B1); PG8_BAR;
            PG8_LDA(At, 1, 1); PG8_STAGE(PG8_SA(1, 0), a3, voffA);
            PG8_BAR; PG8_WAIT_L(0); PG8_MMA(1, 0, At, B0); PG8_BAR; PG8_SCHED;
            PG8_STAGE(PG8_SB(1, 1), b3 + hstep, voffB);
            PG8_WAIT_V(6); PG8_BAR; PG8_MMA(1, 1, At, B1); PG8_BAR;
            }
        }
        if constexpr (ALIGN_EPI) { if (wr == 0) PG8_BAR; }
        if constexpr (!Epi::AFTER_DRAIN) { E(acc, cur, wr, wc, fr, fq); S.done(cur); }
        if (!has_next) break;
#pragma unroll
        for (int a = 0; a < 2; ++a)
#pragma unroll
            for (int b = 0; b < 2; ++b)
#pragma unroll
                for (int m = 0; m < 4; ++m)
#pragma unroll
                    for (int n = 0; n < 2; ++n) acc[a][b][m][n] = (f32x4){0.f, 0.f, 0.f, 0.f};
        cur = nxt; cA = nA; cB = nB; ++ui;
        if constexpr (ALIGN_EPI) { if (wr == 1) PG8_BAR; }
    }
    PG8_WAIT_V(0);
    if constexpr (!ALIGN_EPI) { if (wr == 0) PG8_BAR; }
    PG8_BAR;
    if constexpr (Epi::AFTER_DRAIN) { E.fused(acc, cur, wr, wc, fr, fq, lds, wid, lane); S.done(cur); }
#undef PG8_SA
#undef PG8_SB
#undef PG8_STAGE
#undef PG8_LDA
#undef PG8_LDB
#undef PG8_MMA
#undef PG8_WAIT_V
#undef PG8_WAIT_L
#undef PG8_BAR
#undef PG8_SCHED
}
}
typedef unsigned short bf16_t;
#define DEV __device__ __forceinline__
constexpr int DM = 2048, NB = 4, SEQ = 2048, MTOK = NB * SEQ, CTXL = 256, MCTX = NB * CTXL, FF = 8192, AW = 1024, NH = 8, DH = 128;
constexpr int NAB = 8192, NHY = 6144;
constexpr float EPS = 1e-6f;
constexpr int LDS_BYTES = 163840;
constexpr size_t SZ_W8K = (size_t)8192 * 2048 * 2, SZ_W2K = (size_t)2048 * 2048 * 2;
constexpr size_t OFF_WIN = 0, OFF_WOUT = OFF_WIN + SZ_W8K, OFF_W1_0 = OFF_WOUT + SZ_W2K, OFF_W2_0 = OFF_W1_0 + SZ_W8K, OFF_HYIN = OFF_W2_0 + SZ_W8K,
                 OFF_HYOUT = OFF_HYIN + (size_t)6144 * 2048 * 2, OFF_W1_1 = OFF_HYOUT + SZ_W2K, OFF_W2_1 = OFF_W1_1 + SZ_W8K, OFF_MOD = OFF_W2_1 + SZ_W8K,
                 OFF_HDN = OFF_MOD + 524288, OFF_H = OFF_HDN + 524288, OFF_BIG = OFF_H + (size_t)9216 * 2048 * 2, OFF_Y = OFF_BIG + (size_t)9216 * 8192 * 2,
                 OFF_X1 = OFF_Y + (size_t)8192 * 2048 * 2, OFF_X2 = OFF_X1 + (size_t)8192 * 2048 * 4, OFF_T1 = OFF_X2 + (size_t)8192 * 2048 * 4,
                 OFF_T2 = OFF_T1 + (size_t)67108864, WS_END = OFF_T2 + (size_t)3 * 33554432;

struct Params {
    const float *x, *c, *ctx, *c_ctx, *ada_w, *ada_b, *norm_g, *lb_logits, *ab_w_in, *ab_conv_w, *ab_gnorm_g, *ab_w_out, *hy_in_w, *hy_short_w, *hy_out_w,
        *fw1, *fb1, *fw2, *fb2, *fw3, *fb3, *fw4, *freq, *skip, *w1, *w2, *final_g;
    float* out; unsigned char* ws; int ph_lo, ph_hi;
};

DEV float bf2f(bf16_t b) { return __uint_as_float(((unsigned)b) << 16); }
DEV unsigned pk2(float lo, float hi) { return pg8::cvt_pk_bf16(lo, hi); }
DEV bf16_t f2bf(float v) { return (bf16_t)(pk2(v, 0.f) & 0xffffu); }
DEV float wave_sum(float v) {
#pragma unroll
    for (int o = 1; o < 64; o <<= 1) v += __shfl_xor(v, o);
    return v;
}
DEV float sigm(float x) { return 1.f / (1.f + __expf(-x)); }
DEV float siluf(float x) { return x / (1.f + __expf(-x)); }
DEV void lds_fence() { asm volatile("s_waitcnt lgkmcnt(0)" ::: "memory"); __builtin_amdgcn_wave_barrier(); }

typedef unsigned u32x4v __attribute__((ext_vector_type(4)));
typedef float f32x16 __attribute__((ext_vector_type(16)));
template <int ACT> struct EpiBf16 {
    static constexpr bool PERM = true, AFTER_DRAIN = false;
    bf16_t* O; int ldc;
    __device__ __forceinline__ void operator()(const pg8::f32x4 (&acc)[2][2][4][2], const pg8::Unit& u, int wr, int wc, int fr, int fq) const {
        const int row0 = u.pm * 256 + wr * 64 + fr, col0 = u.pn * 256 + wc * 32 + 8 * fq;
#pragma unroll
        for (int ai = 0; ai < 2; ++ai)
#pragma unroll
            for (int m = 0; m < 4; ++m) { bf16_t* rowp = O + (size_t)(row0 + ai * 128 + m * 16) * ldc + col0;
#pragma unroll
                for (int bj = 0; bj < 2; ++bj) { pg8::f32x4 v0 = acc[ai][bj][m][0], v1 = acc[ai][bj][m][1];
                    if (ACT == 1) {
#pragma unroll
                        for (int e = 0; e < 4; ++e) { float a = fmaxf(v0[e], 0.f), b = fmaxf(v1[e], 0.f); v0[e] = a * a; v1[e] = b * b; } }
                    u32x4v w; w.x = pk2(v0[0], v0[1]); w.y = pk2(v0[2], v0[3]); w.z = pk2(v1[0], v1[1]); w.w = pk2(v1[2], v1[3]);
                    *(u32x4v*)(rowp + bj * 128) = w; } }
    }
};
struct EpiResid {
    static constexpr bool PERM = false, AFTER_DRAIN = false;
    float* C; const float* R; const float* gate; int gstride;
    __device__ __forceinline__ void operator()(const pg8::f32x4 (&acc)[2][2][4][2], const pg8::Unit& u, int wr, int wc, int fr, int fq) const {
        const int row0 = u.pm * 256 + wr * 64 + fr, col0 = u.pn * 256 + wc * 32 + 4 * fq;
        const float* gp = gate + (size_t)((u.pm * 256) >> 11) * gstride + col0;
        pg8::f32x4 gv[2][2];
#pragma unroll
        for (int bj = 0; bj < 2; ++bj)
#pragma unroll
            for (int n = 0; n < 2; ++n) gv[bj][n] = *(const pg8::f32x4*)(gp + bj * 128 + n * 16);
#pragma unroll
        for (int ai = 0; ai < 2; ++ai)
#pragma unroll
            for (int m = 0; m < 4; ++m) { const size_t ro = (size_t)(row0 + ai * 128 + m * 16) * DM + col0;
#pragma unroll
                for (int bj = 0; bj < 2; ++bj)
#pragma unroll
                    for (int n = 0; n < 2; ++n) { const pg8::f32x4 r = *(const pg8::f32x4*)(R + ro + bj * 128 + n * 16);
                        *(pg8::f32x4*)(C + ro + bj * 128 + n * 16) = r + gv[bj][n] * acc[ai][bj][m][n]; } }
    }
};
struct OrderX {
    int nM, nN, nwg, G, c, ex_n, ex_pm0, ex_nN;
    __device__ void init(int M, int N, int G_, int c_, int exn, int expm0, int exnN) { nM = M / 256; nN = N / 256; nwg = nM * nN; G = G_; c = c_; ex_n = exn; ex_pm0 = expm0; ex_nN = exnN; }
    __device__ bool next(int i, pg8::Unit& u) const {
        const long L = (long)i * G + c; if (L >= nwg + ex_n) return false;
        if (L >= nwg) { const int e = (int)L - nwg; u.pm = ex_pm0 + e / ex_nN; u.pn = e % ex_nN; return true; }
        int wgid = (int)L; { const int q = nwg / 8, r = nwg % 8, xcd = wgid % 8, off = wgid / 8; wgid = (xcd < r ? xcd * (q + 1) : r * (q + 1) + (xcd - r) * q) + off; }
        const int nig = 8 * nN, gid = wgid / nig, fm = gid * 8, gsz = (nM - fm) < 8 ? (nM - fm) : 8;
        u.pm = fm + ((wgid % nig) % gsz); u.pn = (wgid % nig) / gsz; return true;
    }
    __device__ __forceinline__ void a_ready(const pg8::Unit&) const {}
    __device__ __forceinline__ void done(const pg8::Unit&) const {}
};

DEV void transpose_item(const float* __restrict__ W, int K, int N, bf16_t* __restrict__ WT, float* scr, int item, int lane) {
    const int nblk = N / 32, kb = item / nblk, nb = item % nblk, k0 = 64 * kb, n0 = 32 * nb;
#pragma unroll 8
    for (int i = 0; i < 32; ++i) { const int kk = 2 * i + (lane >> 5); scr[kk * 33 + (lane & 31)] = W[(size_t)(k0 + kk) * N + n0 + (lane & 31)]; }
    lds_fence();
    const int c = lane & 7;
#pragma unroll
    for (int j = 0; j < 4; ++j) { const int n = (lane >> 3) + 8 * j; const float* s = scr + (8 * c) * 33 + n;
        u32x4v o; o.x = pk2(s[0], s[33]); o.y = pk2(s[2 * 33], s[3 * 33]); o.z = pk2(s[4 * 33], s[5 * 33]); o.w = pk2(s[6 * 33], s[7 * 33]);
        *(u32x4v*)(WT + (size_t)(n0 + n) * K + k0 + 8 * c) = o; }
    lds_fence();
}
DEV void phase_convert(const Params& p, unsigned char* shm) {
    const int wave = threadIdx.x >> 6, lane = threadIdx.x & 63;
    float* scr = (float*)shm + wave * (64 * 33);
    const int gw = blockIdx.x * 8 + wave, NGW = gridDim.x * 8;
    constexpr int I8 = 32 * 256, I2 = 32 * 64, I6 = 32 * 192, IW2 = 128 * 64;
    constexpr int NIT = I8 + I2 + I8 + IW2 + I6 + I2 + I8 + IW2;
    for (int it = gw; it < NIT; it += NGW) {
        int r = it;
        if (r < I8) { transpose_item(p.ab_w_in, 2048, 8192, (bf16_t*)(p.ws + OFF_WIN), scr, r, lane); continue; } r -= I8;
        if (r < I2) { transpose_item(p.ab_w_out, 2048, 2048, (bf16_t*)(p.ws + OFF_WOUT), scr, r, lane); continue; } r -= I2;
        if (r < I8) { transpose_item(p.w1, 2048, 8192, (bf16_t*)(p.ws + OFF_W1_0), scr, r, lane); continue; } r -= I8;
        if (r < IW2) { transpose_item(p.w2, 8192, 2048, (bf16_t*)(p.ws + OFF_W2_0), scr, r, lane); continue; } r -= IW2;
        if (r < I6) { transpose_item(p.hy_in_w, 2048, 6144, (bf16_t*)(p.ws + OFF_HYIN), scr, r, lane); continue; } r -= I6;
        if (r < I2) { transpose_item(p.hy_out_w, 2048, 2048, (bf16_t*)(p.ws + OFF_HYOUT), scr, r, lane); continue; } r -= I2;
        if (r < I8) { transpose_item(p.w1 + (size_t)2048 * 8192, 2048, 8192, (bf16_t*)(p.ws + OFF_W1_1), scr, r, lane); continue; } r -= I8;
        transpose_item(p.w2 + (size_t)8192 * 2048, 8192, 2048, (bf16_t*)(p.ws + OFF_W2_1), scr, r, lane);
    }
    __syncthreads();
}
DEV void phase_ada(const Params& p, unsigned char* shm) {
    float* sil = (float*)shm;
    float* red = sil + 5 * 2080;
    const int tid = threadIdx.x;
    for (int i = tid; i < 5 * 2048; i += 512) { const int m = i >> 11, k = i & 2047; const float v = m < 4 ? p.c[m * 2048 + k] : p.c_ctx[k]; sil[m * 2080 + k + (k >> 6)] = siluf(v); }
    __syncthreads();
    float* MOD = (float*)(p.ws + OFF_MOD);
    const int cq = tid & 15, kg = tid >> 4;
    for (int u = blockIdx.x; u < 384; u += gridDim.x) {
        const int l = u / 192, n0 = (u % 192) * 64;
        float acc[5][4];
#pragma unroll
        for (int m = 0; m < 5; ++m)
#pragma unroll
            for (int e = 0; e < 4; ++e) acc[m][e] = 0.f;
        const float* wp = p.ada_w + ((size_t)l * 2048 + kg * 64) * 12288 + n0 + cq * 4;
#pragma unroll 4
        for (int k = 0; k < 64; ++k) { const pg8::f32x4 w = *(const pg8::f32x4*)(wp + (size_t)k * 12288);
#pragma unroll
            for (int m = 0; m < 5; ++m) { const float s = sil[m * 2080 + kg * 65 + k];
#pragma unroll
                for (int e = 0; e < 4; ++e) acc[m][e] += s * w[e]; } }
#pragma unroll
        for (int m = 0; m < 5; ++m)
#pragma unroll
            for (int e = 0; e < 4; ++e) red[(kg * 5 + m) * 64 + cq * 4 + e] = acc[m][e];
        __syncthreads();
        if (tid < 320) { const int m = tid >> 6, n = tid & 63; float s = p.ada_b[l * 12288 + n0 + n];
            for (int g = 0; g < 32; ++g) s += red[(g * 5 + m) * 64 + n];
            MOD[((size_t)l * 5 + m) * 12288 + n0 + n] = s; }
        __syncthreads();
    }
}
DEV void phase_hdn(const Params& p, unsigned char* shm) {
    float* zb = (float*)shm; float* ha = zb + 512; float* hb = ha + 512;
    float* HDN = (float*)(p.ws + OFF_HDN);
    const int tid = threadIdx.x, pl = tid >> 6, j = tid & 63;
    for (int pb = blockIdx.x; pb < 256; pb += gridDim.x) {
        const int pos = pb * 8 + pl;
        if (j < 33) { float val;
            if (j == 0) val = (float)pos / 2047.f;
            else { const int bi = (j - 1) & 15; const float band = 1e-4f + (float)bi * ((15.f - 1e-4f) / 15.f); const float w = 6.283185307179586f * (float)pos / 2048.f; const float ang = w * band;
                val = (j <= 16) ? cosf(ang) : -sinf(ang); }
            zb[pl * 64 + j] = val; }
        __syncthreads();
        const float fq = p.freq[j];
        float a = p.fb1[j];
#pragma unroll 3
        for (int i = 0; i < 33; ++i) a += zb[pl * 64 + i] * p.fw1[i * 64 + j];
        ha[pl * 64 + j] = sinf(fq * a);
        __syncthreads();
        a = p.fb2[j];
#pragma unroll 4
        for (int i = 0; i < 64; ++i) a += ha[pl * 64 + i] * p.fw2[i * 64 + j];
        hb[pl * 64 + j] = sinf(fq * a);
        __syncthreads();
        a = p.fb3[j];
#pragma unroll 4
        for (int i = 0; i < 64; ++i) a += hb[pl * 64 + i] * p.fw3[i * 64 + j];
        HDN[pos * 64 + j] = sinf(fq * a);
        __syncthreads();
    }
}
DEV void phase_taps(const Params& p) {
    const float* HDN = (const float*)(p.ws + OFF_HDN);
    float* TAPS = (float*)(p.ws + OFF_T1);
    const int lane = threadIdx.x & 63, wv = __builtin_amdgcn_readfirstlane(threadIdx.x >> 6);
    const float min_decay = -3.0701134573253943f, max_decay = -15.350567286626972f;
    for (int unit = blockIdx.x; unit < 2048; unit += gridDim.x) {
        const int pt = unit & 31, dt = (unit >> 5) & 31, o = unit >> 10;
        const int pos = pt * 64 + lane;
        float hd[64];
#pragma unroll
        for (int j = 0; j < 16; ++j) { const pg8::f32x4 v = *(const pg8::f32x4*)(HDN + pos * 64 + 4 * j); hd[4 * j] = v[0]; hd[4 * j + 1] = v[1]; hd[4 * j + 2] = v[2]; hd[4 * j + 3] = v[3]; }
        const float tt = (float)pos / 2047.f;
        for (int cc = 0; cc < 8; ++cc) {
            const int d = dt * 64 + wv * 8 + cc;
            const float* f4 = p.fw4 + o * 4096 + d;
            float af = 0.f, ab = 0.f;
#pragma unroll
            for (int j = 0; j < 64; ++j) { af += hd[j] * f4[j * 8192]; ab += hd[j] * f4[j * 8192 + 2048]; }
            const float delta = fabsf(min_decay + (float)d * ((max_decay - min_decay) / 2047.f));
            const float win = expf(-tt * delta);
            af *= win; ab *= win;
            float* T = TAPS + ((size_t)(o * 2048 + d)) * 4096;
            if (pos == 0) { T[2048] = af + ab; T[0] = 0.f; } else { T[2048 + pos] = af; T[2048 - pos] = ab; }
        }
    }
}
DEV void norm_rows(const float* __restrict__ X, int nrows, int rows_per_batch, const float* __restrict__ g, const float* __restrict__ mod, int mstride, int sh_off, int sc_off, bf16_t* __restrict__ O) {
    const int wave = threadIdx.x >> 6, lane = threadIdx.x & 63;
    const int gw = blockIdx.x * 8 + wave, NGW = gridDim.x * 8;
    for (int row = gw; row < nrows; row += NGW) {
        const pg8::f32x4* xr = (const pg8::f32x4*)(X + (size_t)row * DM) + lane;
        pg8::f32x4 v[8]; float s = 0.f;
#pragma unroll
        for (int j = 0; j < 8; ++j) { v[j] = xr[64 * j]; s += (v[j][0] * v[j][0] + v[j][1] * v[j][1]) + (v[j][2] * v[j][2] + v[j][3] * v[j][3]); }
        const float rstd = rsqrtf(wave_sum(s) * (1.f / DM) + EPS);
        const float* mb = mod + (size_t)(row / rows_per_batch) * mstride;
        unsigned long long* o8 = (unsigned long long*)(O + (size_t)row * DM) + lane;
#pragma unroll
        for (int j = 0; j < 8; ++j) { const int cidx = 4 * (lane + 64 * j);
            const pg8::f32x4 gg = *(const pg8::f32x4*)(g + cidx), sh = *(const pg8::f32x4*)(mb + sh_off + cidx), sc = *(const pg8::f32x4*)(mb + sc_off + cidx);
            float r[4];
#pragma unroll
            for (int e = 0; e < 4; ++e) r[e] = v[j][e] * rstd * gg[e] * (1.f + sc[e]) + sh[e];
            o8[64 * j] = (unsigned long long)pk2(r[0], r[1]) | ((unsigned long long)pk2(r[2], r[3]) << 32); }
    }
}
DEV void final_norm_rows(const float* __restrict__ X, const float* __restrict__ g, float* __restrict__ O) {
    const int wave = threadIdx.x >> 6, lane = threadIdx.x & 63;
    const int gw = blockIdx.x * 8 + wave, NGW = gridDim.x * 8;
    for (int row = gw; row < MTOK; row += NGW) {
        const pg8::f32x4* xr = (const pg8::f32x4*)(X + (size_t)row * DM) + lane;
        pg8::f32x4 v[8]; float s = 0.f;
#pragma unroll
        for (int j = 0; j < 8; ++j) { v[j] = xr[64 * j]; s += (v[j][0] * v[j][0] + v[j][1] * v[j][1]) + (v[j][2] * v[j][2] + v[j][3] * v[j][3]); }
        const float rstd = rsqrtf(wave_sum(s) * (1.f / DM) + EPS);
        pg8::f32x4* orow = (pg8::f32x4*)(O + (size_t)row * DM) + lane;
#pragma unroll
        for (int j = 0; j < 8; ++j) { const pg8::f32x4 gg = *(const pg8::f32x4*)(g + 4 * (lane + 64 * j)); orow[64 * j] = v[j] * rstd * gg; }
    }
}
DEV void phase_convbranch(const Params& p) {
    const bf16_t* PROJ = (const bf16_t*)(p.ws + OFF_BIG);
    bf16_t* Y = (bf16_t*)(p.ws + OFF_Y);
    for (int item = blockIdx.x * 512 + threadIdx.x; item < MTOK * 128; item += gridDim.x * 512) {
        const int row = item >> 7, c = (item & 127) * 8, t = row & 63;
        float acc[8];
#pragma unroll
        for (int e = 0; e < 8; ++e) acc[e] = 0.f;
#pragma unroll
        for (int dt = -1; dt <= 1; ++dt) {
            if ((dt < 0 && t == 0) || (dt > 0 && t == 63)) continue;
            const bf16_t* rp = PROJ + (size_t)(row + dt) * NAB;
            const u32x4v uu = *(const u32x4v*)(rp + 5120 + c), gc = *(const u32x4v*)(rp + 7168 + c);
            const float* w = p.ab_conv_w + (dt + 1) * 1024 + c;
#pragma unroll
            for (int e = 0; e < 4; ++e) { const unsigned a = uu[e], b = gc[e];
                acc[2 * e] += w[2 * e] * (__uint_as_float(a << 16) * __uint_as_float(b << 16));
                acc[2 * e + 1] += w[2 * e + 1] * (__uint_as_float(a & 0xffff0000u) * __uint_as_float(b & 0xffff0000u)); }
        }
        const u32x4v gb = *(const u32x4v*)(PROJ + (size_t)row * NAB + 6144 + c);
        u32x4v o;
#pragma unroll
        for (int e = 0; e < 4; ++e) o[e] = pk2(acc[2 * e] * __uint_as_float(gb[e] << 16), acc[2 * e + 1] * __uint_as_float(gb[e] & 0xffff0000u));
        *(u32x4v*)(Y + (size_t)row * DM + 1024 + c) = o;
    }
}
DEV void phase_scan_naive(const Params& p, unsigned char* shm) {
    float* Fb = (float*)shm;
    float* Kb = Fb + 4096; float* Qb = Kb + 4096;
    float* Vb = Qb + 4096;
    float* Op = Vb + 1024;
    const bf16_t* PROJ = (const bf16_t*)(p.ws + OFF_BIG);
    const bf16_t* CPROJ = PROJ + (size_t)MTOK * NAB;
    float* OFB = (float*)(p.ws + OFF_T1);
    const int tid = threadIdx.x, lane = tid & 63, wave = tid >> 6;
    const int v = tid & 31, kg = tid >> 5;
    const int tl = tid >> 4, kc = (tid & 15) * 8;
    for (int item = blockIdx.x; item < 256; item += gridDim.x) {
        const int vs = item & 3, dir = (item >> 2) & 1, h = (item >> 3) & 7, b = item >> 6;
        float lbv[8];
#pragma unroll
        for (int e = 0; e < 8; ++e) { const float* lp = p.lb_logits + dir * 3072 + h * 128 + kc + e; const float l0 = lp[0], l1 = lp[1024], l2 = lp[2048];
            const float mx = fmaxf(l0, fmaxf(l1, l2)); const float e0 = expf(l0 - mx), e1 = expf(l1 - mx), e2 = expf(l2 - mx); lbv[e] = e0 / (e0 + e1 + e2); }
        float S[8];
#pragma unroll
        for (int e = 0; e < 8; ++e) S[e] = 0.f;
        float* Oout = OFB + (size_t)dir * MTOK * AW;
        for (int batch = 0; batch < 72; ++batch) {
            const int i0 = batch * 32; const bool isctx = i0 < CTXL;
            {
                const int i = i0 + tl;
                const bf16_t* rp;
                if (isctx) { const int tk = dir ? (CTXL - 1 - i) : i; rp = CPROJ + (size_t)(b * CTXL + tk) * NAB; }
                else { const int jj = i - CTXL; const int tk = dir ? (SEQ - 1 - jj) : jj; rp = PROJ + (size_t)(b * SEQ + tk) * NAB; }
                const u32x4v zz = *(const u32x4v*)(rp + dir * 1024 + h * 128 + kc);
                u32x4v qq = {0u, 0u, 0u, 0u};
                if (!isctx) qq = *(const u32x4v*)(rp + 3072 + h * 128 + kc);
#pragma unroll
                for (int e = 0; e < 4; ++e) {
                    const float z0 = __uint_as_float(zz[e] << 16), z1 = __uint_as_float(zz[e] & 0xffff0000u);
                    const float f0 = lbv[2 * e] + (1.f - lbv[2 * e]) * sigm(z0), f1 = lbv[2 * e + 1] + (1.f - lbv[2 * e + 1]) * sigm(z1);
                    Fb[tl * 128 + kc + 2 * e] = f0; Fb[tl * 128 + kc + 2 * e + 1] = f1;
                    Kb[tl * 128 + kc + 2 * e] = 1.f - f0; Kb[tl * 128 + kc + 2 * e + 1] = 1.f - f1;
                    Qb[tl * 128 + kc + 2 * e] = __uint_as_float(qq[e] << 16); Qb[tl * 128 + kc + 2 * e + 1] = __uint_as_float(qq[e] & 0xffff0000u); }
                if (tid < 128) { const int t2 = tid >> 2, vc = (tid & 3) * 8; const int i2 = i0 + t2;
                    const bf16_t* rp2;
                    if (isctx) { const int tk = dir ? (CTXL - 1 - i2) : i2; rp2 = CPROJ + (size_t)(b * CTXL + tk) * NAB; }
                    else { const int jj = i2 - CTXL; const int tk = dir ? (SEQ - 1 - jj) : jj; rp2 = PROJ + (size_t)(b * SEQ + tk) * NAB; }
                    const u32x4v vv = *(const u32x4v*)(rp2 + 2048 + h * 128 + vs * 32 + vc);
#pragma unroll
                    for (int e = 0; e < 4; ++e) { Vb[t2 * 32 + vc + 2 * e] = __uint_as_float(vv[e] << 16); Vb[t2 * 32 + vc + 2 * e + 1] = __uint_as_float(vv[e] & 0xffff0000u); } }
            }
            __syncthreads();
            for (int t = 0; t < 32; ++t) {
                const pg8::f32x4 f0 = *(const pg8::f32x4*)(Fb + t * 128 + kg * 8), f1 = *(const pg8::f32x4*)(Fb + t * 128 + kg * 8 + 4);
                const pg8::f32x4 k0 = *(const pg8::f32x4*)(Kb + t * 128 + kg * 8), k1 = *(const pg8::f32x4*)(Kb + t * 128 + kg * 8 + 4);
                const pg8::f32x4 q0 = *(const pg8::f32x4*)(Qb + t * 128 + kg * 8), q1 = *(const pg8::f32x4*)(Qb + t * 128 + kg * 8 + 4);
                const float vv = Vb[t * 32 + v];
                float o = 0.f;
#pragma unroll
                for (int e = 0; e < 4; ++e) { S[e] = f0[e] * S[e] + k0[e] * vv; o += S[e] * q0[e]; S[4 + e] = f1[e] * S[4 + e] + k1[e] * vv; o += S[4 + e] * q1[e]; }
                o += __shfl_xor(o, 32);
                if (lane < 32) Op[(t * 8 + wave) * 32 + v] = o;
            }
            __syncthreads();
            if (!isctx) {
#pragma unroll
                for (int r = 0; r < 2; ++r) { const int idx = tid + 512 * r, t = idx >> 5, vv = idx & 31;
                    float s = 0.f;
#pragma unroll
                    for (int w = 0; w < 8; ++w) s += Op[(t * 8 + w) * 32 + vv];
                    const int jj = i0 + t - CTXL; const int tk = dir ? (SEQ - 1 - jj) : jj;
                    Oout[(size_t)(b * SEQ + tk) * AW + h * 128 + vs * 32 + vv] = s; }
            }
        }
        __syncthreads();
    }
}
DEV const bf16_t* scan_row(const bf16_t* PROJ, const bf16_t* CPROJ, int b, int dir, int c, int t) {
    const int i = 64 * c + t;
    if (c < 4) { const int tk = dir ? (CTXL - 1 - i) : i; return CPROJ + (size_t)(b * CTXL + tk) * NAB; }
    const int jj = i - CTXL; const int tk = dir ? (SEQ - 1 - jj) : jj; return PROJ + (size_t)(b * SEQ + tk) * NAB;
}
DEV void phase_scan_mfma(const Params& p, unsigned char* shm) {
    unsigned char* Qt = shm;
    unsigned char* Kt = Qt + 17408;
    unsigned char* KtT = Kt + 17408;
    unsigned char* Vt = KtT + 18432;
    unsigned char* Att = Vt + 4608;
    unsigned char* St = Att + 9216;
    float* psum = (float*)(St + 8704);
    float* E1 = psum + 512; float* E2 = E1 + 128;
    const bf16_t* PROJ = (const bf16_t*)(p.ws + OFF_BIG);
    const bf16_t* CPROJ = PROJ + (size_t)MTOK * NAB;
    float* OFB = (float*)(p.ws + OFF_T1);
    const int tid = threadIdx.x, lane = tid & 63, wave = __builtin_amdgcn_readfirstlane(tid >> 6);
    const int k = tid & 127, tq = tid >> 7, vv = tid & 31, tg = tid >> 5, r = lane & 31, hh = lane >> 5;
    for (int item = blockIdx.x; item < 256; item += gridDim.x) {
        const int vs = item & 3, dir = (item >> 2) & 1, h = (item >> 3) & 7, b = item >> 6;
        float lb;
        { const float* lp = p.lb_logits + dir * 3072 + h * 128 + k; const float l0 = lp[0], l1 = lp[1024], l2 = lp[2048];
          const float mx = fmaxf(l0, fmaxf(l1, l2)); const float e0 = expf(l0 - mx), e1 = expf(l1 - mx), e2 = expf(l2 - mx); lb = e0 / (e0 + e1 + e2); }
        float* Oout = OFB + (size_t)dir * MTOK * AW;
        f32x16 S;
#pragma unroll
        for (int i = 0; i < 16; ++i) S[i] = 0.f;
        unsigned short zr[16], qr[16], vr[4];
        const int zcol = dir * 1024 + h * 128 + k, qcol = 3072 + h * 128 + k, vcol = 2048 + h * 128 + vs * 32 + vv;
#define SCAN_LOAD(cidx) do { const int c_ = (cidx); \
        _Pragma("unroll") for (int i_ = 0; i_ < 16; ++i_) { const bf16_t* rp_ = scan_row(PROJ, CPROJ, b, dir, c_, 16 * tq + i_); zr[i_] = rp_[zcol]; qr[i_] = c_ < 4 ? (unsigned short)0 : rp_[qcol]; } \
        _Pragma("unroll") for (int i_ = 0; i_ < 4; ++i_) { const bf16_t* rp_ = scan_row(PROJ, CPROJ, b, dir, c_, 4 * tg + i_); vr[i_] = rp_[vcol]; } } while (0)
        SCAN_LOAD(0);
        for (int c = 0; c < 36; ++c) {
            const bool isctx = c < 4;
            float bl[16], kk[16], qf[16]; float run = 0.f;
#pragma unroll
            for (int i = 0; i < 16; ++i) { const float z = bf2f(zr[i]); const float f = lb + (1.f - lb) * sigm(z); run += __logf(f); bl[i] = run; kk[i] = 1.f - f; qf[i] = bf2f(qr[i]); }
            const unsigned long long vpack = (unsigned long long)vr[0] | ((unsigned long long)vr[1] << 16) | ((unsigned long long)vr[2] << 32) | ((unsigned long long)vr[3] << 48);
            psum[tq * 128 + k] = run;
            if (c + 1 < 36) SCAN_LOAD(c + 1);
            __syncthreads();
            const float p0 = psum[k], p1 = psum[128 + k], p2 = psum[256 + k], p3 = psum[384 + k];
            const float rho = p0 + p1, blast = (p0 + p1) + (p2 + p3);
            const float off = tq == 0 ? 0.f : (tq == 1 ? p0 : (tq == 2 ? rho : rho + p2));
            unsigned kt_pk[8];
#pragma unroll
            for (int i = 0; i < 16; i += 2) {
                const float a0 = fminf(fmaxf(off + bl[i] - rho, -80.f), 80.f), a1 = fminf(fmaxf(off + bl[i + 1] - rho, -80.f), 80.f);
                const float eq0 = __expf(a0), eq1 = __expf(a1), ek0 = __expf(-a0), ek1 = __expf(-a1);
                const unsigned qq = pk2(qf[i] * eq0, qf[i + 1] * eq1), kq = pk2(kk[i] * ek0, kk[i + 1] * ek1);
                const int t = 16 * tq + i;
                *(unsigned short*)(Qt + t * 272 + k * 2) = (unsigned short)(qq & 0xffffu); *(unsigned short*)(Qt + (t + 1) * 272 + k * 2) = (unsigned short)(qq >> 16);
                *(unsigned short*)(Kt + t * 272 + k * 2) = (unsigned short)(kq & 0xffffu); *(unsigned short*)(Kt + (t + 1) * 272 + k * 2) = (unsigned short)(kq >> 16);
                kt_pk[i >> 1] = kq;
            }
            *(u32x4v*)(KtT + k * 144 + (16 * tq) * 2) = (u32x4v){kt_pk[0], kt_pk[1], kt_pk[2], kt_pk[3]};
            *(u32x4v*)(KtT + k * 144 + (16 * tq + 8) * 2) = (u32x4v){kt_pk[4], kt_pk[5], kt_pk[6], kt_pk[7]};
            *(unsigned long long*)(Vt + vv * 144 + (4 * tg) * 2) = vpack;
            if (tq == 0) { E1[k] = __expf(fmaxf(rho, -80.f)); E2[k] = __expf(fmaxf(blast - rho, -80.f)); }
            __syncthreads();
            if (wave < 4) {
#pragma unroll
                for (int rg = 0; rg < 4; ++rg) { const int k0 = 32 * wave + 8 * rg + 4 * hh; const pg8::f32x4 e1 = *(const pg8::f32x4*)(E1 + k0);
#pragma unroll
                    for (int e = 0; e < 4; ++e) S[4 * rg + e] *= e1[e];
                    *(unsigned long long*)(St + r * 272 + k0 * 2) = (unsigned long long)pk2(S[4 * rg], S[4 * rg + 1]) | ((unsigned long long)pk2(S[4 * rg + 2], S[4 * rg + 3]) << 32); }
            } else if (!isctx && wave >= 5) {
                const int si = wave == 7 ? 1 : 0, ti = wave == 5 ? 0 : 1;
                f32x16 acc;
#pragma unroll
                for (int i = 0; i < 16; ++i) acc[i] = 0.f;
#pragma unroll
                for (int ks = 0; ks < 8; ++ks) { const pg8::bf16x8 a = *(const pg8::bf16x8*)(Kt + (32 * si + r) * 272 + (16 * ks + 8 * hh) * 2), bq = *(const pg8::bf16x8*)(Qt + (32 * ti + r) * 272 + (16 * ks + 8 * hh) * 2);
                    acc = __builtin_amdgcn_mfma_f32_32x32x16_bf16(a, bq, acc, 0, 0, 0); }
                const int t = 32 * ti + r;
#pragma unroll
                for (int rg = 0; rg < 4; ++rg) { const int s0 = 32 * si + 8 * rg + 4 * hh; float m[4];
#pragma unroll
                    for (int e = 0; e < 4; ++e) m[e] = (s0 + e <= t) ? acc[4 * rg + e] : 0.f;
                    *(unsigned long long*)(Att + t * 144 + s0 * 2) = (unsigned long long)pk2(m[0], m[1]) | ((unsigned long long)pk2(m[2], m[3]) << 32); }
            }
            __syncthreads();
            if (wave < 4) {
#pragma unroll
                for (int ks = 0; ks < 4; ++ks) { const pg8::bf16x8 a = *(const pg8::bf16x8*)(KtT + (32 * wave + r) * 144 + (16 * ks + 8 * hh) * 2), bv = *(const pg8::bf16x8*)(Vt + r * 144 + (16 * ks + 8 * hh) * 2);
                    S = __builtin_amdgcn_mfma_f32_32x32x16_bf16(a, bv, S, 0, 0, 0); }
#pragma unroll
                for (int rg = 0; rg < 4; ++rg) { const pg8::f32x4 e2 = *(const pg8::f32x4*)(E2 + 32 * wave + 8 * rg + 4 * hh);
#pragma unroll
                    for (int e = 0; e < 4; ++e) S[4 * rg + e] *= e2[e]; }
            } else if (!isctx && wave < 6) {
                const int ti = wave - 4;
                f32x16 acc;
#pragma unroll
                for (int i = 0; i < 16; ++i) acc[i] = 0.f;
#pragma unroll
                for (int ks = 0; ks < 8; ++ks) { const pg8::bf16x8 a = *(const pg8::bf16x8*)(Qt + (32 * ti + r) * 272 + (16 * ks + 8 * hh) * 2), bs = *(const pg8::bf16x8*)(St + r * 272 + (16 * ks + 8 * hh) * 2);
                    acc = __builtin_amdgcn_mfma_f32_32x32x16_bf16(a, bs, acc, 0, 0, 0); }
                const int nks = ti == 0 ? 2 : 4;
                for (int ks = 0; ks < nks; ++ks) { const pg8::bf16x8 a = *(const pg8::bf16x8*)(Att + (32 * ti + r) * 144 + (16 * ks + 8 * hh) * 2), bv = *(const pg8::bf16x8*)(Vt + r * 144 + (16 * ks + 8 * hh) * 2);
                    acc = __builtin_amdgcn_mfma_f32_32x32x16_bf16(a, bv, acc, 0, 0, 0); }
#pragma unroll
                for (int i = 0; i < 16; ++i) { const int t = 32 * ti + (i & 3) + 8 * (i >> 2) + 4 * hh; const int jj = 64 * (c - 4) + t; const int tk = dir ? (SEQ - 1 - jj) : jj;
                    Oout[(size_t)(b * SEQ + tk) * AW + h * 128 + vs * 32 + r] = acc[i]; }
            }
        }
        __syncthreads();
#undef SCAN_LOAD
    }
}
DEV void phase_readout(const Params& p) {
    const bf16_t* PROJ = (const bf16_t*)(p.ws + OFF_BIG);
    const float* OF = (const float*)(p.ws + OFF_T1); const float* OB = OF + (size_t)MTOK * AW;
    bf16_t* Y = (bf16_t*)(p.ws + OFF_Y);
    const int wave = threadIdx.x >> 6, lane = threadIdx.x & 63;
    const int gw = blockIdx.x * 8 + wave, NGW = gridDim.x * 8;
    for (int row = gw; row < MTOK; row += NGW) {
        const int c0 = lane * 16;
        float o[16]; float ss = 0.f;
#pragma unroll
        for (int j = 0; j < 4; ++j) { const pg8::f32x4 a = *(const pg8::f32x4*)(OF + (size_t)row * AW + c0 + 4 * j), bq = *(const pg8::f32x4*)(OB + (size_t)row * AW + c0 + 4 * j);
#pragma unroll
            for (int e = 0; e < 4; ++e) { o[4 * j + e] = a[e] + bq[e]; ss += o[4 * j + e] * o[4 * j + e]; } }
        ss += __shfl_xor(ss, 1); ss += __shfl_xor(ss, 2); ss += __shfl_xor(ss, 4);
        const float rstd = rsqrtf(ss * (1.f / DH) + EPS);
#pragma unroll
        for (int hh = 0; hh < 2; ++hh) {
            const u32x4v gg = *(const u32x4v*)(PROJ + (size_t)row * NAB + 4096 + c0 + 8 * hh);
            u32x4v w;
#pragma unroll
            for (int e = 0; e < 4; ++e) { const int ci = 8 * hh + 2 * e;
                const float g0 = __uint_as_float(gg[e] << 16), g1 = __uint_as_float(gg[e] & 0xffff0000u);
                w[e] = pk2(o[ci] * rstd * p.ab_gnorm_g[c0 + ci] * siluf(g0), o[ci + 1] * rstd * p.ab_gnorm_g[c0 + ci + 1] * siluf(g1)); }
            *(u32x4v*)(Y + (size_t)row * DM + c0 + 8 * hh) = w; }
    }
}
DEV void phase_hyprep(const Params& p, unsigned char* shm) {
    const bf16_t* P = (const bf16_t*)(p.ws + OFF_BIG);
    bf16_t* T2 = (bf16_t*)(p.ws + OFF_T2);
    const int wave = threadIdx.x >> 6, lane = threadIdx.x & 63;
    float* scr = (float*)shm + wave * (64 * 65);
    const int gw = blockIdx.x * 8 + wave, NGW = gridDim.x * 8;
    for (int it = gw; it < 128 * 96; it += NGW) {
        const int ct = it % 96, tt = it / 96, tok0 = tt * 64, c0 = ct * 64;
#pragma unroll 8
        for (int i = 0; i < 64; ++i) scr[i * 65 + lane] = bf2f(P[(size_t)(tok0 + i) * NHY + c0 + lane]);
        lds_fence();
        const int which = c0 >> 11;
        bf16_t* dst = T2 + (size_t)which * (2048 * 8192) + (size_t)(c0 - which * 2048) * 8192 + tok0 + lane;
        for (int cc = 0; cc < 64; ++cc) {
            const float w0 = p.hy_short_w[c0 + cc], w1 = p.hy_short_w[NHY + c0 + cc], w2 = p.hy_short_w[2 * NHY + c0 + cc];
            const float cen = scr[lane * 65 + cc];
            const float lf = lane > 0 ? scr[(lane - 1) * 65 + cc] : 0.f;
            const float rt = lane < 63 ? scr[(lane + 1) * 65 + cc] : 0.f;
            dst[(size_t)cc * 8192] = f2bf(w0 * lf + w1 * cen + w2 * rt);
        }
        lds_fence();
    }
    __syncthreads();
}
DEV void phase_longconv_naive(const Params& p, unsigned char* shm) {
    float* Tn = (float*)shm; float* Za = Tn + 4096; float* Zb = Za + 8192; float* red = Zb + 8192;
    bf16_t* T2 = (bf16_t*)(p.ws + OFF_T2);
    const float* TAPS = (const float*)(p.ws + OFF_T1);
    const int tid = threadIdx.x, lane = tid & 63, wave = tid >> 6;
    for (int d = blockIdx.x; d < DM; d += gridDim.x) {
        bf16_t* ZT = T2 + (size_t)2 * (2048 * 8192) + (size_t)d * 8192;
        const bf16_t* X1T = T2 + (size_t)d * 8192; const bf16_t* X2T = T2 + (size_t)(2048 * 8192) + (size_t)d * 8192;
        for (int idx = tid; idx < 8192; idx += 512) Za[idx] = bf2f(ZT[idx]);
        for (int o = 0; o < 2; ++o) {
            const float* T = TAPS + ((size_t)(o * 2048 + d)) * 4096;
            float tv[8]; float s = 0.f;
#pragma unroll
            for (int r = 0; r < 8; ++r) { tv[r] = T[tid + 512 * r]; s += fabsf(tv[r]); }
            s = wave_sum(s); if (lane == 0) red[wave] = s;
            __syncthreads();
            float tot = 0.f;
#pragma unroll
            for (int w = 0; w < 8; ++w) tot += red[w];
            const float inv = 1.f / tot;
#pragma unroll
            for (int r = 0; r < 8; ++r) Tn[tid + 512 * r] = tv[r] * inv;
            __syncthreads();
            const float* src = o == 0 ? Za : Zb; float* dst = o == 0 ? Zb : Za;
            float acc[4][4];
#pragma unroll
            for (int b = 0; b < 4; ++b)
#pragma unroll
                for (int j = 0; j < 4; ++j) acc[b][j] = 0.f;
            for (int si = 0; si < 512; ++si) {
                const int m0 = 4 * (tid - si) + 2048;
                const pg8::f32x4 lo = *(const pg8::f32x4*)(Tn + m0 - 4), hi = *(const pg8::f32x4*)(Tn + m0);
                float tw[8]; tw[0] = lo[0]; tw[1] = lo[1]; tw[2] = lo[2]; tw[3] = lo[3]; tw[4] = hi[0]; tw[5] = hi[1]; tw[6] = hi[2]; tw[7] = hi[3];
#pragma unroll
                for (int b = 0; b < 4; ++b) { const pg8::f32x4 zz = *(const pg8::f32x4*)(src + b * 2048 + 4 * si);
#pragma unroll
                    for (int j = 0; j < 4; ++j)
#pragma unroll
                        for (int i = 0; i < 4; ++i) acc[b][j] += tw[4 + j - i] * zz[i]; }
            }
            const float skip = p.skip[o * 2048 + d];
            const bf16_t* gate = o == 0 ? X1T : X2T;
            float res[4][4];
#pragma unroll
            for (int b = 0; b < 4; ++b)
#pragma unroll
                for (int j = 0; j < 4; ++j) { const int t = 4 * tid + j; res[b][j] = bf2f(gate[b * 2048 + t]) * (acc[b][j] + src[b * 2048 + t] * skip); }
#pragma unroll
            for (int b = 0; b < 4; ++b)
#pragma unroll
                for (int j = 0; j < 4; ++j) dst[b * 2048 + 4 * tid + j] = res[b][j];
            __syncthreads();
        }
        for (int idx = tid; idx < 8192; idx += 512) ZT[idx] = f2bf(Za[idx]);
        __syncthreads();
    }
}
DEV void phase_longconv_mfma(const Params& p, unsigned char* shm) {
    unsigned char* TC = shm;
    unsigned char* ZA = shm + 65792;
    unsigned char* ZB = ZA + 25600;
    float* red = (float*)(ZB + 25600);
    bf16_t* T2 = (bf16_t*)(p.ws + OFF_T2);
    const float* TAPS = (const float*)(p.ws + OFF_T1);
    const int tid = threadIdx.x, lane = tid & 63, wave = __builtin_amdgcn_readfirstlane(tid >> 6);
    for (int i = tid; i < 2 * 64 * 5; i += 512) { const int bufi = i / 320, r = i % 320, hc = r / 5, part = r % 5; const int col = hc < 32 ? hc : 256 + hc;
        *(u32x4v*)((bufi ? ZB : ZA) + col * 80 + part * 16) = (u32x4v){0u, 0u, 0u, 0u}; }
    const int nt = wave, n = lane & 31, g = lane >> 5, il = n & 7, ih = n >> 3;
    const int dlo = (8 * nt - 63) > -63 ? (8 * nt - 63) : -63, dhi = (8 * nt + 7) < 63 ? (8 * nt + 7) : 63;
    for (int d = blockIdx.x; d < DM; d += gridDim.x) {
        bf16_t* ZT = T2 + (size_t)2 * (2048 * 8192) + (size_t)d * 8192;
        const bf16_t* X1T = T2 + (size_t)d * 8192; const bf16_t* X2T = T2 + (size_t)(2048 * 8192) + (size_t)d * 8192;
        __syncthreads();
#pragma unroll
        for (int r = 0; r < 2; ++r) { const int e0 = (tid + 512 * r) * 8, b = e0 >> 11, t = e0 & 2047, s1 = t >> 5, s2 = t & 31;
            *(u32x4v*)(ZA + ((4 * s1 + b + 32) * 40 + s2) * 2) = *(const u32x4v*)(ZT + e0); }
        for (int o = 0; o < 2; ++o) {
            {
                const float* T = TAPS + ((size_t)(o * 2048 + d)) * 4096;
                const int mb = 4088 - 8 * tid;
                float v[16];
#pragma unroll
                for (int i = 0; i < 4; ++i) { pg8::f32x4 f = {0.f, 0.f, 0.f, 0.f}; if (mb + 4 * i < 4096) f = *(const pg8::f32x4*)(T + mb + 4 * i);
                    v[4 * i] = f[0]; v[4 * i + 1] = f[1]; v[4 * i + 2] = f[2]; v[4 * i + 3] = f[3]; }
                float s = 0.f;
#pragma unroll
                for (int i = 8; i < 16; ++i) s += fabsf(v[i]);
                if (tid == 511) {
#pragma unroll
                    for (int i = 1; i < 8; ++i) s += fabsf(v[i]); }
                s = wave_sum(s); if (lane == 0) red[o * 8 + wave] = s;
#pragma unroll
                for (int c = 0; c < 8; ++c) { u32x4v w; w.x = pk2(v[8 + c], v[7 + c]); w.y = pk2(v[6 + c], v[5 + c]); w.z = pk2(v[4 + c], v[3 + c]); w.w = pk2(v[2 + c], v[1 + c]);
                    *(u32x4v*)(TC + c * 8224 + tid * 16) = w; }
            }
            __syncthreads();
            float tot = 0.f;
#pragma unroll
            for (int w = 0; w < 8; ++w) tot += red[o * 8 + w];
            const float inv = 1.f / tot;
            unsigned char* src = o == 0 ? ZA : ZB;
            const unsigned char* ap = TC + il * 8224 + 2 * (2048 + 8 * (g - ih)) - 64 * dlo;
            const unsigned char* bp = src + ((32 * nt + n + 32) * 40 + 8 * g) * 2 - 320 * dlo;
            f32x16 acc0, acc1;
#pragma unroll
            for (int i = 0; i < 16; ++i) { acc0[i] = 0.f; acc1[i] = 0.f; }
            pg8::bf16x8 a0 = *(const pg8::bf16x8*)ap, a1 = *(const pg8::bf16x8*)(ap + 32), b0 = *(const pg8::bf16x8*)bp, b1 = *(const pg8::bf16x8*)(bp + 32);
            for (int dl = dlo; dl < dhi; ++dl) {
                ap -= 64; bp -= 320;
                const pg8::bf16x8 na0 = *(const pg8::bf16x8*)ap, na1 = *(const pg8::bf16x8*)(ap + 32), nb0 = *(const pg8::bf16x8*)bp, nb1 = *(const pg8::bf16x8*)(bp + 32);
                acc0 = __builtin_amdgcn_mfma_f32_32x32x16_bf16(a0, b0, acc0, 0, 0, 0);
                acc1 = __builtin_amdgcn_mfma_f32_32x32x16_bf16(a1, b1, acc1, 0, 0, 0);
                a0 = na0; a1 = na1; b0 = nb0; b1 = nb1;
            }
            acc0 = __builtin_amdgcn_mfma_f32_32x32x16_bf16(a0, b0, acc0, 0, 0, 0);
            acc1 = __builtin_amdgcn_mfma_f32_32x32x16_bf16(a1, b1, acc1, 0, 0, 0);
            const float skip = p.skip[o * 2048 + d];
            const bf16_t* gate = o == 0 ? X1T : X2T;
            const int j = n >> 2, b = n & 3, t1 = 8 * nt + j;
#pragma unroll
            for (int rg = 0; rg < 4; ++rg) {
                const int t2 = 8 * rg + 4 * g, gidx = b * 2048 + 32 * t1 + t2, lo = ((4 * t1 + b + 32) * 40 + t2) * 2;
                const unsigned long long gg = *(const unsigned long long*)(gate + gidx), zz = *(const unsigned long long*)(src + lo);
                float val[4];
#pragma unroll
                for (int e = 0; e < 4; ++e) { const float gv = __uint_as_float((unsigned)((gg >> (16 * e)) & 0xffffull) << 16), zv = __uint_as_float((unsigned)((zz >> (16 * e)) & 0xffffull) << 16);
                    val[e] = gv * (inv * (acc0[4 * rg + e] + acc1[4 * rg + e]) + zv * skip); }
                const unsigned long long ov = (unsigned long long)pk2(val[0], val[1]) | ((unsigned long long)pk2(val[2], val[3]) << 32);
                if (o == 0) *(unsigned long long*)(ZB + lo) = ov; else *(unsigned long long*)(ZT + gidx) = ov;
            }
            __syncthreads();
        }
    }
}
DEV void phase_transback(const Params& p, unsigned char* shm) {
    const bf16_t* ZT = (const bf16_t*)(p.ws + OFF_T2) + (size_t)2 * (2048 * 8192);
    bf16_t* Y = (bf16_t*)(p.ws + OFF_Y);
    const int wave = threadIdx.x >> 6, lane = threadIdx.x & 63;
    unsigned short* scr = (unsigned short*)shm + wave * (64 * 66);
    const int gw = blockIdx.x * 8 + wave, NGW = gridDim.x * 8;
    for (int it = gw; it < 32 * 128; it += NGW) {
        const int ct = it & 31, tt = it >> 5, c0 = ct * 64, tok0 = tt * 64;
#pragma unroll 8
        for (int i = 0; i < 64; ++i) scr[i * 66 + lane] = ZT[(size_t)(c0 + i) * 8192 + tok0 + lane];
        lds_fence();
#pragma unroll 8
        for (int t = 0; t < 64; ++t) Y[(size_t)(tok0 + t) * DM + c0 + lane] = scr[lane * 66 + t];
        lds_fence();
    }
    __syncthreads();
}

enum { P_PREP = 0, P_NORM0, P_GEMM_IN, P_SCAN, P_READOUT, P_GEMM_OUT0, P_NORM0B, P_GEMM_UP0, P_GEMM_DN0, P_NORM1, P_GEMM_HYIN, P_HYPREP, P_LCONV, P_TRANSB,
       P_GEMM_OUT1, P_NORM1B, P_GEMM_UP1, P_GEMM_DN1, P_FINAL, NPHASE };

template <int KK, int NN, class Epi>
DEV void run_gemm(unsigned char* shm, const bf16_t* A, const bf16_t* Bt, const Epi& E, int exn, int expm0, int exnN) {
    pg8::Gemm g; g.A = A; g.Bt = Bt; g.M = MTOK; g.N = NN; g.K = KK;
    OrderX S; S.init(MTOK, NN, gridDim.x, blockIdx.x, exn, expm0, exnN);
    pg8::gemm_phase<Epi, OrderX, true, true>((PG8_LAS unsigned char*)shm, g, S, E);
}

__global__ __launch_bounds__(512, 2) void mega(Params p) {
    extern __shared__ __attribute__((aligned(16))) unsigned char shm[];
    cg::grid_group grid = cg::this_grid();
    const int lo = p.ph_lo, hi = p.ph_hi;
#ifndef KEEPMASK
#define KEEPMASK 0xFFFFFFFFu
#endif
#define IN(k) ((((KEEPMASK) >> (k)) & 1u) && lo <= (k) && (k) < hi)
#define SEAM(k) do { if (IN(k) && IN((k) + 1)) grid.sync(); } while (0)
#define WS(T, off) ((T*)(p.ws + (off)))
    if (IN(P_PREP)) {
#ifndef NO_ADA
        phase_ada(p, shm); __syncthreads();
#endif
#ifndef NO_HDN
        phase_hdn(p, shm); __syncthreads();
#endif
#ifndef NO_CONV
        phase_convert(p, shm);
#endif
    }
    SEAM(P_PREP);
    if (IN(P_NORM0)) {
        norm_rows(p.x, MTOK, SEQ, p.norm_g, WS(float, OFF_MOD), 12288, 0, DM, WS(bf16_t, OFF_H));
        norm_rows(p.ctx, MCTX, MCTX, p.norm_g, WS(float, OFF_MOD) + (size_t)4 * 12288, 0, 0, DM, WS(bf16_t, OFF_H) + (size_t)MTOK * DM);
    }
    SEAM(P_NORM0);
    if (IN(P_GEMM_IN)) { EpiBf16<0> E; E.O = WS(bf16_t, OFF_BIG); E.ldc = NAB; run_gemm<2048, NAB>(shm, WS(bf16_t, OFF_H), WS(bf16_t, OFF_WIN), E, 48, 32, 12); }
    SEAM(P_GEMM_IN);
    if (IN(P_SCAN)) { phase_convbranch(p); phase_scan_mfma(p, shm); }
    SEAM(P_SCAN);
    if (IN(P_READOUT)) phase_readout(p);
    SEAM(P_READOUT);
    if (IN(P_GEMM_OUT0)) { EpiResid E; E.gstride = 12288; E.R = p.x; E.C = WS(float, OFF_X1); E.gate = WS(float, OFF_MOD) + 2 * DM;
        run_gemm<2048, DM>(shm, WS(bf16_t, OFF_Y), WS(bf16_t, OFF_WOUT), E, 0, 0, 1); }
    SEAM(P_GEMM_OUT0);
    if (IN(P_NORM0B)) norm_rows(WS(float, OFF_X1), MTOK, SEQ, p.norm_g + DM, WS(float, OFF_MOD), 12288, 3 * DM, 4 * DM, WS(bf16_t, OFF_H));
    SEAM(P_NORM0B);
    if (IN(P_GEMM_UP0)) { EpiBf16<1> E; E.O = WS(bf16_t, OFF_BIG); E.ldc = FF; run_gemm<2048, FF>(shm, WS(bf16_t, OFF_H), WS(bf16_t, OFF_W1_0), E, 0, 0, 1); }
    SEAM(P_GEMM_UP0);
    if (IN(P_GEMM_DN0)) { EpiResid E; E.gstride = 12288; E.R = WS(float, OFF_X1); E.C = WS(float, OFF_X2); E.gate = WS(float, OFF_MOD) + 5 * DM;
        run_gemm<8192, DM>(shm, WS(bf16_t, OFF_BIG), WS(bf16_t, OFF_W2_0), E, 0, 0, 1); }
    SEAM(P_GEMM_DN0);
    if (IN(P_NORM1)) { norm_rows(WS(float, OFF_X2), MTOK, SEQ, p.norm_g + 2 * DM, WS(float, OFF_MOD) + (size_t)5 * 12288, 12288, 0, DM, WS(bf16_t, OFF_H)); phase_taps(p); }
    SEAM(P_NORM1);
    if (IN(P_GEMM_HYIN)) { EpiBf16<0> E; E.O = WS(bf16_t, OFF_BIG); E.ldc = NHY; run_gemm<2048, NHY>(shm, WS(bf16_t, OFF_H), WS(bf16_t, OFF_HYIN), E, 0, 0, 1); }
    SEAM(P_GEMM_HYIN);
    if (IN(P_HYPREP)) phase_hyprep(p, shm);
    SEAM(P_HYPREP);
    if (IN(P_LCONV)) phase_longconv_mfma(p, shm);
    SEAM(P_LCONV);
    if (IN(P_TRANSB)) phase_transback(p, shm);
    SEAM(P_TRANSB);
    if (IN(P_GEMM_OUT1)) { EpiResid E; E.gstride = 12288; E.R = WS(float, OFF_X2); E.C = WS(float, OFF_X1); E.gate = WS(float, OFF_MOD) + (size_t)5 * 12288 + 2 * DM;
        run_gemm<2048, DM>(shm, WS(bf16_t, OFF_Y), WS(bf16_t, OFF_HYOUT), E, 0, 0, 1); }
    SEAM(P_GEMM_OUT1);
    if (IN(P_NORM1B)) norm_rows(WS(float, OFF_X1), MTOK, SEQ, p.norm_g + 3 * DM, WS(float, OFF_MOD) + (size_t)5 * 12288, 12288, 3 * DM, 4 * DM, WS(bf16_t, OFF_H));
    SEAM(P_NORM1B);
    if (IN(P_GEMM_UP1)) { EpiBf16<1> E; E.O = WS(bf16_t, OFF_BIG); E.ldc = FF; run_gemm<2048, FF>(shm, WS(bf16_t, OFF_H), WS(bf16_t, OFF_W1_1), E, 0, 0, 1); }
    SEAM(P_GEMM_UP1);
    if (IN(P_GEMM_DN1)) { EpiResid E; E.gstride = 12288; E.R = WS(float, OFF_X1); E.C = WS(float, OFF_X2); E.gate = WS(float, OFF_MOD) + (size_t)5 * 12288 + 5 * DM;
        run_gemm<8192, DM>(shm, WS(bf16_t, OFF_BIG), WS(bf16_t, OFF_W2_1), E, 0, 0, 1); }
    SEAM(P_GEMM_DN1);
    if (IN(P_FINAL)) final_norm_rows(WS(float, OFF_X2), p.final_g, p.out);
#undef IN
#undef SEAM
#undef WS
}

extern "C" void kernel_launch(void* const* d_in, const int* in_sizes, int n_in, void* d_out, int out_size, void* d_ws, size_t ws_size, hipStream_t stream) {
    static int grid = 0;
    if (grid == 0) {
        if (n_in != 27 || ws_size < WS_END) { fprintf(stderr, "kernel_launch: unexpected n_in %d or workspace %zu < %zu\n", n_in, ws_size, (size_t)WS_END); grid = -1; return; }
        int dev = 0, cus = 0, per_cu = 0;
        hipGetDevice(&dev); hipDeviceGetAttribute(&cus, hipDeviceAttributeMultiprocessorCount, dev);
        if (hipFuncSetAttribute((const void*)mega, hipFuncAttributeMaxDynamicSharedMemorySize, LDS_BYTES) != hipSuccess) { fprintf(stderr, "kernel_launch: hipFuncSetAttribute failed\n"); grid = -1; return; }
        if (hipOccupancyMaxActiveBlocksPerMultiprocessor(&per_cu, (const void*)mega, 512, LDS_BYTES) != hipSuccess || per_cu < 1) { fprintf(stderr, "kernel_launch: occupancy query gave %d\n", per_cu); per_cu = 1; }
        (void)hipGetLastError();
        grid = cus * per_cu;
    }
    if (grid < 0) return;
    Params p{};
    const float** f = (const float**)&p;
    for (int i = 0; i < 27; ++i) f[i] = (const float*)d_in[i];
    p.out = (float*)d_out; p.ws = (unsigned char*)d_ws; p.ph_lo = 0; p.ph_hi = NPHASE;
    void* args[] = {&p};
    hipError_t e = hipLaunchCooperativeKernel((const void*)mega, dim3(grid), dim3(512), args, LDS_BYTES, stream);
    if (e != hipSuccess) fprintf(stderr, "cooperative launch failed: %s (grid %d)\n", hipGetErrorString(e), grid);
}
```
